# Optimizing an MI355X kernel written in HIP

```python
import math
import jax, jax.numpy as jnp
from jax import lax
import numpy as np

D_MODEL = 1024
BATCH = 8
SEQ = 2048
DEPTH = 1

MEM_LEN = 256
EPS = 1e-6
NEG_INF = -1e30
BIG = 1e30

NSA_HEADS = 16
NSA_GROUPS = 4
NSA_HPG = NSA_HEADS // NSA_GROUPS
NSA_DH = 64
NSA_SCALE = NSA_DH ** -0.5
CMP_BLOCK = 32
CMP_STRIDE = 16
CMP_HIDDEN = 128
SEL_BLOCK = 64
SEL_TOPK = 16
N_LOCAL_FORCED = 2
WINDOW = 512
SEL_QBLOCK = 32
WIN_QBLOCK = 128

ML_HEADS = 4
ML_DH = 128
ML_CHUNK = 64
CONV_WIDTH = 4

MEM_HEADS = 4
MEM_DH = 128
MEM_SCALE = MEM_DH ** -0.5

D_FF = -(-8 * D_MODEL // (3 * 256)) * 256

N_BRANCH = 3
NSA_Q = NSA_HEADS * NSA_DH
NSA_KV = NSA_GROUPS * NSA_DH
ML_W = ML_HEADS * ML_DH
MEM_W = MEM_HEADS * MEM_DH
IN_SPLITS = (NSA_Q, 6 * NSA_KV, 3 * NSA_HEADS, 3 * ML_W, 2 * ML_HEADS, ML_W, MEM_W, N_BRANCH * D_MODEL)
IN_WIDTH = NSA_Q + 6 * NSA_KV + 3 * NSA_HEADS + 3 * ML_W + 2 * ML_HEADS + ML_W + MEM_W + N_BRANCH * D_MODEL

kernel_name = "hybrid_nsa_mlstm_memxattn_block"


def rmsnorm(x, g):
    xf = x.astype(jnp.float32)
    y = xf * lax.rsqrt(jnp.mean(xf * xf, axis=-1, keepdims=True) + EPS)
    return (y * g.astype(jnp.float32)).astype(x.dtype)


def masked_softmax(s, mask):
    s = jnp.where(mask, s.astype(jnp.float32), NEG_INF)
    return jax.nn.softmax(s, axis=-1) * mask


def compress_blocks(kv, pe, w1, w2):
    S = kv.shape[1]
    n_cmp = (S - CMP_BLOCK) // CMP_STRIDE + 1
    idx = jnp.arange(n_cmp)[:, None] * CMP_STRIDE + jnp.arange(CMP_BLOCK)[None, :]
    blocks = kv[:, idx] + pe[None, None, :, None, :]
    hid = jax.nn.silu(jnp.einsum('bnlgd,ldh->bngh', blocks, w1))
    return jnp.einsum('bngh,hd->bngd', hid, w2)


def nsa_compressed(q, k, v, pe_k, w1_k, w2_k, pe_v, w1_v, w2_v):
    S = q.shape[1]
    kc = compress_blocks(k, pe_k, w1_k, w2_k)
    vc = compress_blocks(v, pe_v, w1_v, w2_v)
    n_cmp = kc.shape[1]
    s = jnp.einsum('bsghd,bngd->bghsn', q, kc) * NSA_SCALE
    t = jnp.arange(S)
    end = jnp.arange(n_cmp) * CMP_STRIDE + CMP_BLOCK - 1
    p = masked_softmax(s, end[None, :] <= t[:, None])
    o = jnp.einsum('bghsn,bngd->bsghd', p.astype(vc.dtype), vc)
    return o, p


def cmp_to_sel_map(n_cmp, n_sel):
    c0 = jnp.arange(n_cmp) * CMP_STRIDE
    s0 = jnp.arange(n_sel) * SEL_BLOCK
    ov = jnp.minimum(c0[:, None] + CMP_BLOCK, s0[None, :] + SEL_BLOCK) - jnp.maximum(c0[:, None], s0[None, :])
    return jnp.clip(ov, 0, None).astype(jnp.float32) / CMP_BLOCK


def nsa_select(p_cmp, S):
    n_cmp = p_cmp.shape[-1]
    n_sel = S // SEL_BLOCK
    imp = jnp.einsum('bghsn,nj->bgsj', p_cmp, cmp_to_sel_map(n_cmp, n_sel))
    qblk = jnp.arange(S) // SEL_BLOCK
    j = jnp.arange(n_sel)
    rel = qblk[:, None] - j[None, :]
    causal = rel >= 0
    forced = causal & ((j[None, :] == 0) | (rel < N_LOCAL_FORCED))
    score = jnp.where(forced, BIG, jnp.where(causal, imp, NEG_INF))
    top_s, top_i = lax.top_k(score, min(SEL_TOPK, n_sel))
    return top_i, top_s > 0.5 * NEG_INF


def nsa_selected(q, k, v, top_i, top_ok):
    B, S, G, HPG, dh = q.shape
    n_sel = S // SEL_BLOCK
    nk = top_i.shape[-1]
    nq = S // SEL_QBLOCK
    kb = k.reshape(B, n_sel, SEL_BLOCK, G, dh).transpose(0, 3, 1, 2, 4)
    vb = v.reshape(B, n_sel, SEL_BLOCK, G, dh).transpose(0, 3, 1, 2, 4)
    qb = jnp.moveaxis(q.reshape(B, nq, SEL_QBLOCK, G, HPG, dh), 1, 0)
    ib = jnp.moveaxis(top_i.reshape(B, G, nq, SEL_QBLOCK, nk), 2, 0)
    mb = jnp.moveaxis(top_ok.reshape(B, G, nq, SEL_QBLOCK, nk), 2, 0)
    bi = jnp.arange(B)[:, None, None, None]
    gi = jnp.arange(G)[None, :, None, None]

    def body(args):
        qi, ii, mi, blk = args
        kg = kb[bi, gi, ii]
        vg = vb[bi, gi, ii]
        tpos = blk * SEL_QBLOCK + jnp.arange(SEL_QBLOCK)
        kpos = ii[..., None] * SEL_BLOCK + jnp.arange(SEL_BLOCK)
        mask = mi[..., None] & (kpos <= tpos[None, None, :, None, None])
        s = jnp.einsum('bqghd,bgqnld->bghqnl', qi, kg) * NSA_SCALE
        p = masked_softmax(s.reshape(B, G, HPG, SEL_QBLOCK, nk * SEL_BLOCK),
                           mask.reshape(B, G, 1, SEL_QBLOCK, nk * SEL_BLOCK))
        p = p.reshape(B, G, HPG, SEL_QBLOCK, nk, SEL_BLOCK).astype(vg.dtype)
        return jnp.einsum('bghqnl,bgqnld->bqghd', p, vg)

    out = lax.map(body, (qb, ib, mb, jnp.arange(nq)))
    return jnp.moveaxis(out, 0, 1).reshape(B, S, G, HPG, dh)


def nsa_window(q, k, v):
    B, S, G, HPG, dh = q.shape
    nq = S // WIN_QBLOCK
    span = WIN_QBLOCK + WINDOW
    kp = jnp.pad(k, ((0, 0), (WINDOW, 0), (0, 0), (0, 0)))
    vp = jnp.pad(v, ((0, 0), (WINDOW, 0), (0, 0), (0, 0)))
    qb = jnp.moveaxis(q.reshape(B, nq, WIN_QBLOCK, G, HPG, dh), 1, 0)

    def body(args):
        qi, blk = args
        start = blk * WIN_QBLOCK
        ks = lax.dynamic_slice_in_dim(kp, start, span, axis=1)
        vs = lax.dynamic_slice_in_dim(vp, start, span, axis=1)
        tpos = start + jnp.arange(WIN_QBLOCK)
        kpos = start - WINDOW + jnp.arange(span)
        d = tpos[:, None] - kpos[None, :]
        mask = (d >= 0) & (d < WINDOW) & (kpos[None, :] >= 0)
        s = jnp.einsum('bqghd,bkgd->bghqk', qi, ks) * NSA_SCALE
        p = masked_softmax(s, mask).astype(vs.dtype)
        return jnp.einsum('bghqk,bkgd->bqghd', p, vs)

    out = lax.map(body, (qb, jnp.arange(nq)))
    return jnp.moveaxis(out, 0, 1).reshape(B, S, G, HPG, dh)


def causal_conv(x, w, b):
    C = x.shape[-1]
    y = lax.conv_general_dilated(x, w[:, None, :], window_strides=(1,), padding=[(CONV_WIDTH - 1, 0)],
                                 dimension_numbers=('NWC', 'WIO', 'NWC'), feature_group_count=C)
    return y + b


def mlstm_chunkwise(q, k, v, i_pre, logf):
    B, S, H, dh = q.shape
    L = ML_CHUNK
    nc = S // L
    q = q.astype(jnp.float32)
    k = k.astype(jnp.float32) * (dh ** -0.5)
    v = v.astype(jnp.float32)

    def chunks(a):
        return jnp.moveaxis(a.reshape(B, nc, L, *a.shape[2:]), 1, 0)

    tril = jnp.tril(jnp.ones((L, L), dtype=bool))

    def step(carry, xs):
        C, n, m = carry
        qj, kj, vj, ij, fj = xs
        qh = qj.transpose(0, 2, 1, 3)
        kh = kj.transpose(0, 2, 1, 3)
        vh = vj.transpose(0, 2, 1, 3)
        b = jnp.cumsum(fj, axis=1).transpose(0, 2, 1)
        ih = ij.transpose(0, 2, 1)
        dlog = jnp.where(tril, b[..., :, None] - b[..., None, :] + ih[..., None, :], -jnp.inf)
        inter = b + m[..., None]
        m_t = jnp.maximum(inter, jnp.max(dlog, axis=-1))
        dw = jnp.exp(dlog - m_t[..., None])
        iw = jnp.exp(inter - m_t)
        sqk = jnp.einsum('bhld,bhsd->bhls', qh, kh) * dw
        num = jnp.einsum('bhls,bhsd->bhld', sqk, vh) + iw[..., None] * jnp.einsum('bhed,bhld->bhle', C, qh)
        den = jnp.sum(sqk, axis=-1) + iw * jnp.einsum('bhd,bhld->bhl', n, qh)
        h = num / jnp.maximum(jnp.abs(den), jnp.exp(-m_t))[..., None]
        b_end = b[..., -1]
        wlog = b_end[..., None] - b + ih
        m_new = jnp.maximum(b_end + m, jnp.max(wlog, axis=-1))
        ws = jnp.exp(wlog - m_new[..., None])
        decay = jnp.exp(b_end + m - m_new)
        C_new = decay[..., None, None] * C + jnp.einsum('bhs,bhse,bhsd->bhed', ws, vh, kh)
        n_new = decay[..., None] * n + jnp.einsum('bhs,bhsd->bhd', ws, kh)
        return (C_new, n_new, m_new), h

    init = (jnp.zeros((B, H, dh, dh), jnp.float32), jnp.zeros((B, H, dh), jnp.float32), jnp.zeros((B, H), jnp.float32))
    _, hs = lax.scan(step, init, (chunks(q), chunks(k), chunks(v), chunks(i_pre), chunks(logf)))
    return hs.transpose(1, 0, 3, 2, 4).reshape(B, S, H, dh)


def memory_xattn(q, mem, g, w_kv):
    B, S, _ = q.shape
    M = mem.shape[1]
    kv = rmsnorm(mem, g) @ w_kv
    k = kv[..., :MEM_W].reshape(B, M, MEM_HEADS, MEM_DH)
    v = kv[..., MEM_W:].reshape(B, M, MEM_HEADS, MEM_DH)
    qh = q.reshape(B, S, MEM_HEADS, MEM_DH)
    s = jnp.einsum('bshd,bmhd->bhsm', qh, k).astype(jnp.float32) * MEM_SCALE
    p = jax.nn.softmax(s, axis=-1).astype(v.dtype)
    return jnp.einsum('bhsm,bmhd->bshd', p, v).reshape(B, S, MEM_W)


def setup_inputs(seed: int = 0) -> dict:
    key = jax.random.key(seed)
    ks = jax.random.split(key, 32)
    L = DEPTH

    def nrm(k, shape, scale):
        return jax.random.normal(k, shape, jnp.float32) * scale

    def gain(k, shape):
        return 1.0 + 0.05 * jax.random.normal(k, shape, jnp.float32)

    gate_b = jnp.concatenate([
        0.1 * jax.random.normal(ks[10], (L, ML_HEADS), jnp.float32),
        jnp.linspace(3.0, 6.0, ML_HEADS, dtype=jnp.float32)[None, :] + 0.1 * jax.random.normal(ks[11], (L, ML_HEADS), jnp.float32),
    ], axis=-1)
    return {
        "x": nrm(ks[0], (BATCH, SEQ, D_MODEL), 1.0),
        "mem": nrm(ks[1], (BATCH, MEM_LEN, D_MODEL), 1.0),
        "g_pre_mix": gain(ks[2], (L, D_MODEL)),
        "w_in": nrm(ks[3], (L, D_MODEL, IN_WIDTH), D_MODEL ** -0.5),
        "cmp_pe_k": nrm(ks[4], (L, CMP_BLOCK, NSA_DH), 0.1),
        "cmp_w1_k": nrm(ks[5], (L, CMP_BLOCK, NSA_DH, CMP_HIDDEN), (CMP_BLOCK * NSA_DH) ** -0.5),
        "cmp_w2_k": nrm(ks[6], (L, CMP_HIDDEN, NSA_DH), CMP_HIDDEN ** -0.5),
        "cmp_pe_v": nrm(ks[7], (L, CMP_BLOCK, NSA_DH), 0.1),
        "cmp_w1_v": nrm(ks[8], (L, CMP_BLOCK, NSA_DH, CMP_HIDDEN), (CMP_BLOCK * NSA_DH) ** -0.5),
        "cmp_w2_v": nrm(ks[9], (L, CMP_HIDDEN, NSA_DH), CMP_HIDDEN ** -0.5),
        "ml_conv_w": nrm(ks[12], (L, CONV_WIDTH, 2 * ML_W), CONV_WIDTH ** -0.5),
        "ml_conv_b": nrm(ks[13], (L, 2 * ML_W), 0.02),
        "ml_gate_b": gate_b,
        "ml_head_g": gain(ks[14], (L, ML_W)),
        "g_mem": gain(ks[15], (L, D_MODEL)),
        "w_mem_kv": nrm(ks[16], (L, D_MODEL, 2 * MEM_W), D_MODEL ** -0.5),
        "w_proj_nsa": nrm(ks[17], (L, NSA_Q, D_MODEL), NSA_Q ** -0.5),
        "w_proj_ml": nrm(ks[18], (L, ML_W, D_MODEL), ML_W ** -0.5),
        "w_proj_mem": nrm(ks[19], (L, MEM_W, D_MODEL), MEM_W ** -0.5),
        "w_out": nrm(ks[20], (L, D_MODEL, D_MODEL), D_MODEL ** -0.5),
        "g_post_mix": gain(ks[21], (L, D_MODEL)),
        "g_pre_ffn": gain(ks[22], (L, D_MODEL)),
        "w_ffn_in": nrm(ks[23], (L, D_MODEL, 2 * D_FF), D_MODEL ** -0.5),
        "w_ffn_down": nrm(ks[24], (L, D_FF, D_MODEL), D_FF ** -0.5),
        "g_post_ffn": gain(ks[25], (L, D_MODEL)),
    }


def reference(x, mem, g_pre_mix, w_in, cmp_pe_k, cmp_w1_k, cmp_w2_k, cmp_pe_v, cmp_w1_v, cmp_w2_v,
              ml_conv_w, ml_conv_b, ml_gate_b, ml_head_g, g_mem, w_mem_kv, w_proj_nsa, w_proj_ml,
              w_proj_mem, w_out, g_post_mix, g_pre_ffn, w_ffn_in, w_ffn_down, g_post_ffn):
    B, S, _ = x.shape
    offsets = np.cumsum(IN_SPLITS)[:-1].tolist()
    for l in range(DEPTH):
        h = rmsnorm(x, g_pre_mix[l])
        z = h @ w_in[l]
        q_nsa, kv_nsa, g_nsa, qkv_ml, if_ml, o_ml, q_mem, g_merge = jnp.split(z, offsets, axis=-1)

        q = q_nsa.reshape(B, S, NSA_GROUPS, NSA_HPG, NSA_DH)
        kv = kv_nsa.reshape(B, S, 6, NSA_GROUPS, NSA_DH)
        o_cmp, p_cmp = nsa_compressed(q, kv[:, :, 0], kv[:, :, 1], cmp_pe_k[l], cmp_w1_k[l], cmp_w2_k[l],
                                      cmp_pe_v[l], cmp_w1_v[l], cmp_w2_v[l])
        top_i, top_ok = nsa_select(p_cmp, S)
        o_slc = nsa_selected(q, kv[:, :, 2], kv[:, :, 3], top_i, top_ok)
        o_win = nsa_window(q, kv[:, :, 4], kv[:, :, 5])
        gb = jax.nn.sigmoid(g_nsa.reshape(B, S, NSA_GROUPS, NSA_HPG, 3))
        y_nsa = (gb[..., 0:1] * o_cmp + gb[..., 1:2] * o_slc + gb[..., 2:3] * o_win).reshape(B, S, NSA_Q)

        qk = jax.nn.silu(causal_conv(qkv_ml[..., :2 * ML_W], ml_conv_w[l], ml_conv_b[l]))
        q_m = qk[..., :ML_W].reshape(B, S, ML_HEADS, ML_DH)
        k_m = qk[..., ML_W:].reshape(B, S, ML_HEADS, ML_DH)
        v_m = qkv_ml[..., 2 * ML_W:].reshape(B, S, ML_HEADS, ML_DH)
        gates = if_ml.astype(jnp.float32) + ml_gate_b[l].astype(jnp.float32)
        i_pre = gates[..., :ML_HEADS]
        logf = jax.nn.log_sigmoid(gates[..., ML_HEADS:])
        h_ml = mlstm_chunkwise(q_m, k_m, v_m, i_pre, logf)
        h_ml = h_ml * lax.rsqrt(jnp.mean(h_ml * h_ml, axis=-1, keepdims=True) + EPS)
        h_ml = h_ml.reshape(B, S, ML_W) * ml_head_g[l].astype(jnp.float32)
        y_ml = (jax.nn.sigmoid(o_ml.astype(jnp.float32)) * h_ml).astype(x.dtype)

        y_mem = memory_xattn(q_mem, mem, g_mem[l], w_mem_kv[l])

        gm = jax.nn.sigmoid(g_merge.reshape(B, S, N_BRANCH, D_MODEL))
        y = (gm[:, :, 0] * (y_nsa @ w_proj_nsa[l]) + gm[:, :, 1] * (y_ml @ w_proj_ml[l])
             + gm[:, :, 2] * (y_mem @ w_proj_mem[l]))
        x = x + rmsnorm(y @ w_out[l], g_post_mix[l])

        h = rmsnorm(x, g_pre_ffn[l])
        gu = h @ w_ffn_in[l]
        gate, up = gu[..., :D_FF], gu[..., D_FF:]
        x = x + rmsnorm((jax.nn.silu(gate) * up) @ w_ffn_down[l], g_post_ffn[l])
    return x
```

```cpp
#include <hip/hip_runtime.h>
#include <hip/hip_cooperative_groups.h>
#include <cstdio>
namespace cg = cooperative_groups;

#ifndef COOP
#define COOP 1
#endif
#ifndef ITEM_MASK
#define ITEM_MASK 7
#endif
#ifndef ONLY
#define ONLY -1
#endif

typedef unsigned short u16;
using bf16x8 = __attribute__((ext_vector_type(8))) short;
using s16x4  = __attribute__((ext_vector_type(4))) short;
using f32x16 = __attribute__((ext_vector_type(16))) float;
typedef __attribute__((ext_vector_type(2))) __bf16 bf2_t;
typedef __attribute__((ext_vector_type(2))) float f2_t;
typedef __attribute__((ext_vector_type(4))) unsigned u32x4;

#define DI __device__ __forceinline__
#define MFMA(a, b, c) __builtin_amdgcn_mfma_f32_32x32x16_bf16((a), (b), (c), 0, 0, 0)

constexpr int T_TOK = 16384;
constexpr int ZW = 5120;
constexpr int LDS_BYTES = 73728;
constexpr int LDS_TOTAL = LDS_BYTES + 64;

struct Params {
  const float *x, *mem, *g_pre_mix, *w_in, *pe_k, *w1_k, *w2_k, *pe_v, *w1_v, *w2_v, *conv_w, *conv_b, *gate_b,
      *head_g, *g_mem, *w_mem_kv, *w_pn, *w_pml, *w_pmem, *w_out, *g_post_mix, *g_pre_ffn, *w_ffin, *w_ffdn, *g_post_ffn;
  float* out;
  u16 *z, *hbuf, *WinT, *WffT, *WdnT, *WmkvT, *WpnT, *WpmlT, *WpmemT, *WoutT, *W1kT, *W1vT, *memn, *kvm, *kc, *vc;
  float *zf, *ssp, *ssp2, *cbias, *mlsc, *mlba;
  u16* halo;
  int* ctr;
  unsigned* bar;
  u16 *ybuf, *act;
  u16 *t1, *t2;
};

DI unsigned pk2(float a, float b) { f2_t v; v[0] = a; v[1] = b; bf2_t p = __builtin_convertvector(v, bf2_t); return __builtin_bit_cast(unsigned, p); }
DI u16 f2bf(float a) { return (u16)(pk2(a, 0.f) & 0xffffu); }
DI float bf2f(u16 v) { return __uint_as_float(((unsigned)v) << 16); }
DI float bflo(unsigned u) { return __uint_as_float(u << 16); }
DI float bfhi(unsigned u) { return __uint_as_float(u & 0xffff0000u); }
DI float sigmoidf_(float x) { return __builtin_amdgcn_rcpf(1.0f + __expf(-x)); }
DI float siluf_(float x) { return x * __builtin_amdgcn_rcpf(1.0f + __expf(-x)); }
DI float ex2(float x) { return __builtin_amdgcn_exp2f(x); }
DI s16x4 tr_read(const char* p) {
  return __builtin_amdgcn_ds_read_tr16_b64_v4i16((s16x4 __attribute__((address_space(3)))*)(p));
}
DI bf16x8 cat8(s16x4 a, s16x4 b) { return __builtin_shufflevector(a, b, 0, 1, 2, 3, 4, 5, 6, 7); }
DI bf16x8 tr_pair(const char* p, int rowstep4) { return cat8(tr_read(p), tr_read(p + rowstep4)); }
DI bf16x8 pack8(const f32x16& x, int s) {
  unsigned p0 = pk2(x[8 * s + 0], x[8 * s + 1]), p1 = pk2(x[8 * s + 2], x[8 * s + 3]);
  unsigned p2 = pk2(x[8 * s + 4], x[8 * s + 5]), p3 = pk2(x[8 * s + 6], x[8 * s + 7]);
  uint4 u = make_uint4(p0, p1, p2, p3);
  return __builtin_bit_cast(bf16x8, u);
}
DI f32x16 zero16() { f32x16 z; for (int i = 0; i < 16; ++i) z[i] = 0.f; return z; }
typedef float f32x4v __attribute__((ext_vector_type(4)));
typedef unsigned u32x2v __attribute__((ext_vector_type(2)));
DI float4 ldnt4(const float* p) { const f32x4v v = __builtin_nontemporal_load((const f32x4v*)p); return make_float4(v.x, v.y, v.z, v.w); }
DI void stnt4(float* p, float4 v) { f32x4v w = {v.x, v.y, v.z, v.w}; __builtin_nontemporal_store(w, (f32x4v*)p); }
DI uint2 ldnt2u(const u16* p) { const u32x2v v = __builtin_nontemporal_load((const u32x2v*)p); return make_uint2(v.x, v.y); }
DI float wave_sum(float v) { for (int o = 32; o >= 1; o >>= 1) v += __shfl_xor(v, o); return v; }

#define XB_TMO      128
#define XB_XCNT(j)  (256  + 64 * (j))
#define XB_XSUB(j)  (1280 + 64 * (j))
#define XB_XGEN(j)  (2304 + 64 * (j))
#define XB_TOP      3328
#define XB_TOPGEN   3392
#define XCD_BAR_WORDS 3456
#define XB_SPIN_CAP (1u << 18)
#define LAS __attribute__((address_space(3)))

__device__ __forceinline__ unsigned xb_ld(unsigned* p)              { return __hip_atomic_load(p, __ATOMIC_RELAXED, __HIP_MEMORY_SCOPE_AGENT); }
__device__ __forceinline__ unsigned xb_add(unsigned* p, unsigned v) { return __hip_atomic_fetch_add(p, v, __ATOMIC_RELAXED, __HIP_MEMORY_SCOPE_AGENT); }
__device__ __forceinline__ unsigned xb_xcc_id() { return (unsigned)__builtin_amdgcn_s_getreg((3 << 11) | 20) & 0xFu; }
#define XB_SPIN(cond, bar) do { unsigned _sp = 0; while (cond) { __builtin_amdgcn_s_sleep(1); \
    if ((++_sp & 255u) == 0u) { if (xb_ld(&(bar)[XB_TMO])) break; if (_sp > XB_SPIN_CAP) { atomicAdd(&(bar)[XB_TMO], 1u); break; } } } } while (0)

struct XcdBarrier {
    unsigned* bar; unsigned x;
    volatile LAS unsigned* st;
};

__device__ __forceinline__ XcdBarrier xcd_barrier_post(unsigned* bar, volatile LAS unsigned* st) {
    XcdBarrier b; b.bar = bar; b.x = xb_xcc_id(); b.st = st;
    if (threadIdx.x == 0) (void)xb_add(&bar[XB_XCNT(b.x)], 1u);
    return b;
}
__device__ __forceinline__ void xcd_barrier_complete(unsigned* bar, unsigned x, unsigned& nloc, unsigned& nx) {
    const unsigned G = gridDim.x * gridDim.y * gridDim.z;
    unsigned sum, cnt, mine, sp = 0u;
    for (;;) {
        sum = 0u; cnt = 0u; mine = 0u;
#pragma unroll
        for (unsigned j = 0; j < 16; ++j) { const unsigned c = xb_ld(&bar[XB_XCNT(j)]); sum += c; cnt += (c > 0u) ? 1u : 0u; mine = (j == x) ? c : mine; }
        if (sum == G) break;
        __builtin_amdgcn_s_sleep(1);
        if ((++sp & 255u) == 0u) { if (xb_ld(&bar[XB_TMO])) break; if (sp > XB_SPIN_CAP) { atomicAdd(&bar[XB_TMO], 1u); break; } }
    }
    nloc = mine > 0u ? mine : 1u; nx = cnt > 0u ? cnt : 1u;
}

__device__ __forceinline__ void xcd_barrier(const XcdBarrier& b, int tid_) {
    asm volatile("s_waitcnt vmcnt(0)" ::: "memory");
    __syncthreads();
    if (tid_ == 0) {
        unsigned* bar = b.bar;
        __builtin_amdgcn_s_waitcnt(0);
        unsigned nloc = b.st[0], nx = b.st[1];
        if (nloc == 0u) { xcd_barrier_complete(bar, b.x, nloc, nx); b.st[0] = nloc; b.st[1] = nx; }
        const unsigned old = xb_add(&bar[XB_XSUB(b.x)], 1u);
        const unsigned gen = old / nloc;
        if (old + 1u == (gen + 1u) * nloc) {
            __builtin_amdgcn_fence(__ATOMIC_RELEASE, "agent");
            asm volatile("s_waitcnt vmcnt(0)" ::: "memory");
            const unsigned og = xb_add(&bar[XB_TOP], 1u);
            const unsigned tg = og / nx;
            if (og + 1u == (tg + 1u) * nx) xb_add(&bar[XB_TOPGEN], 1u);
            else XB_SPIN(xb_ld(&bar[XB_TOPGEN]) == tg, bar);
            __builtin_amdgcn_fence(__ATOMIC_ACQUIRE, "agent");
            xb_add(&bar[XB_XGEN(b.x)], 1u);
            asm volatile("s_waitcnt vmcnt(0)" ::: "memory");
        } else {
            XB_SPIN(xb_ld(&bar[XB_XGEN(b.x)]) == gen, bar);
            __builtin_amdgcn_fence(__ATOMIC_ACQUIRE, "agent");
            asm volatile("s_waitcnt vmcnt(0)" ::: "memory");
        }
    }
    __syncthreads();
}


struct APlain {
  const u16* base; long ld;
  DI const u16* operator()(int row, int k) const { return base + (long)row * ld + k; }
};
struct ACmp {
  const u16* zb; int row0;
  DI const u16* operator()(int row, int k) const {
    int rg = row0 + row; int n = rg >> 2; if (n > 126) n = 126; int g = rg & 3;
    return zb + (long)(16 * n + (k >> 6)) * ZW + g * 64 + (k & 63);
  }
};

template <bool LOWREG = false, class AP>
DI void gemm_kloop(f32x16 (&acc)[2][2], const AP& ap, const u16* Bt, long ldb, int K, char* lds, int tid) {
  asm volatile("" : "+v"(tid));
  const int lane = tid & 63, w = tid >> 6, wm = w >> 1, wn = w & 1, r = lane & 31, h = lane >> 5;
  const int lrow = tid >> 3, lk = (tid & 7) * 8;
  const int nk = K >> 6;
#define G_LOAD(RA, RB, KT) { const int k0_ = (KT) * 64 + lk; _Pragma("unroll") for (int i = 0; i < 4; ++i) { \
      RA[i] = *(const u32x4*)ap(lrow + 32 * i, k0_); RB[i] = *(const u32x4*)(Bt + (long)(lrow + 32 * i) * ldb + k0_); } }
#define G_STORE(RA, RB, BUF) { char* lw_ = lds + (BUF) * 36864; _Pragma("unroll") for (int i = 0; i < 4; ++i) { \
      *(u32x4*)(lw_ + (lrow + 32 * i) * 144 + lk * 2) = RA[i]; *(u32x4*)(lw_ + 18432 + (lrow + 32 * i) * 144 + lk * 2) = RB[i]; } }
#define G_COMPUTE(BUF) { const char* la_ = lds + (BUF) * 36864 + (wm * 64 + r) * 144 + h * 16; \
    const char* lb_ = lds + (BUF) * 36864 + 18432 + (wn * 64 + r) * 144 + h * 16; \
    _Pragma("unroll") for (int ks = 0; ks < 4; ++ks) { \
      bf16x8 a0 = *(const bf16x8*)(la_ + ks * 32), a1 = *(const bf16x8*)(la_ + 32 * 144 + ks * 32); \
      bf16x8 b0 = *(const bf16x8*)(lb_ + ks * 32), b1 = *(const bf16x8*)(lb_ + 32 * 144 + ks * 32); \
      acc[0][0] = MFMA(b0, a0, acc[0][0]); acc[0][1] = MFMA(b1, a0, acc[0][1]); \
      acc[1][0] = MFMA(b0, a1, acc[1][0]); acc[1][1] = MFMA(b1, a1, acc[1][1]); } }
  if (LOWREG) {
    u32x4 ra[4], rb[4];
    G_LOAD(ra, rb, 0);
    G_STORE(ra, rb, 0);
    __syncthreads();
    for (int kt = 0; kt < nk; ++kt) {
      const int buf = kt & 1;
      G_COMPUTE(buf);
      if (kt + 1 < nk) { G_LOAD(ra, rb, kt + 1); G_STORE(ra, rb, buf ^ 1); }
      __syncthreads();
    }
  } else {
    u32x4 ra0[4], rb0[4], ra1[4], rb1[4];
    G_LOAD(ra0, rb0, 0);
    G_LOAD(ra1, rb1, (nk > 1 ? 1 : 0));
    G_STORE(ra0, rb0, 0);
    __syncthreads();
    for (int kt = 0; kt < nk; kt += 2) {
      G_LOAD(ra0, rb0, (kt + 2 < nk ? kt + 2 : nk - 1));
      G_COMPUTE(0);
      if (kt + 1 < nk) G_STORE(ra1, rb1, 1);
      __syncthreads();
      if (kt + 1 < nk) {
        G_LOAD(ra1, rb1, (kt + 3 < nk ? kt + 3 : nk - 1));
        G_COMPUTE(1);
        if (kt + 2 < nk) G_STORE(ra0, rb0, 0);
        __syncthreads();
      }
    }
  }
#undef G_LOAD
#undef G_STORE
#undef G_COMPUTE
}

#define EPI_M(mi) (wm * 64 + (mi) * 32 + r)
#define EPI_N(ni, i) (wn * 64 + (ni) * 32 + ((i) & 3) + 8 * ((i) >> 2) + 4 * h)

DI void store_tile_bf16(const f32x16 (&acc)[2][2], u16* dst, long ldd, char* lds, int tid, u16* halo = nullptr, int grow0 = 0) {
  asm volatile("" : "+v"(tid));
  const int lane = tid & 63, w = tid >> 6, wm = w >> 1, wn = w & 1, r = lane & 31, h = lane >> 5;
#pragma unroll
  for (int mi = 0; mi < 2; ++mi)
#pragma unroll
    for (int ni = 0; ni < 2; ++ni)
#pragma unroll
      for (int a4 = 0; a4 < 4; ++a4) {
        uint2 u; u.x = pk2(acc[mi][ni][4 * a4], acc[mi][ni][4 * a4 + 1]); u.y = pk2(acc[mi][ni][4 * a4 + 2], acc[mi][ni][4 * a4 + 3]);
        *(uint2*)(lds + EPI_M(mi) * 272 + EPI_N(ni, 4 * a4) * 2) = u;
      }
  __syncthreads();
#pragma unroll
  for (int i = 0; i < 8; ++i) {
    const int c = tid + 256 * i, row = c >> 4, cc = c & 15;
    const u32x4 v = *(const u32x4*)(lds + row * 272 + cc * 16);
    *(u32x4*)(dst + (long)row * ldd + cc * 8) = v;
    if (halo && ((row & 63) >= 61)) {
      const int grow = grow0 + row;
      *(u32x4*)(halo + ((long)(grow >> 6) * 3 + ((grow & 63) - 61)) * 1024 + cc * 8) = v;
    }
  }
  __syncthreads();
}

template <class AP>
DI void gemm_kloop64(f32x16 (&acc)[2], const AP& ap, const u16* Bt, long ldb, int K, char* lds, int tid) {
  asm volatile("" : "+v"(tid));
  const int lane = tid & 63, w = tid >> 6, wm = w >> 1, wn = w & 1, r = lane & 31, h = lane >> 5;
  const int lrow = tid >> 3, lk = (tid & 7) * 8;
  const int nk = K >> 6;
#define J_LOAD(RA, RB, KT) { const int k0_ = (KT) * 64 + lk; \
    _Pragma("unroll") for (int i = 0; i < 2; ++i) RA[i] = *(const u32x4*)ap(lrow + 32 * i, k0_); \
    _Pragma("unroll") for (int i = 0; i < 4; ++i) RB[i] = *(const u32x4*)(Bt + (long)(lrow + 32 * i) * ldb + k0_); }
#define J_STORE(RA, RB, BUF) { char* lw_ = lds + (BUF) * 27648; \
    _Pragma("unroll") for (int i = 0; i < 2; ++i) *(u32x4*)(lw_ + (lrow + 32 * i) * 144 + lk * 2) = RA[i]; \
    _Pragma("unroll") for (int i = 0; i < 4; ++i) *(u32x4*)(lw_ + 9216 + (lrow + 32 * i) * 144 + lk * 2) = RB[i]; }
#define J_COMPUTE(BUF) { const char* la_ = lds + (BUF) * 27648 + (wm * 32 + r) * 144 + h * 16; \
    const char* lb_ = lds + (BUF) * 27648 + 9216 + (wn * 64 + r) * 144 + h * 16; \
    _Pragma("unroll") for (int ks = 0; ks < 4; ++ks) { \
      bf16x8 a_ = *(const bf16x8*)(la_ + ks * 32); \
      bf16x8 b0 = *(const bf16x8*)(lb_ + ks * 32), b1 = *(const bf16x8*)(lb_ + 32 * 144 + ks * 32); \
      acc[0] = MFMA(b0, a_, acc[0]); acc[1] = MFMA(b1, a_, acc[1]); } }
  u32x4 ra0[2], rb0[4], ra1[2], rb1[4];
  J_LOAD(ra0, rb0, 0);
  J_LOAD(ra1, rb1, (nk > 1 ? 1 : 0));
  J_STORE(ra0, rb0, 0);
  __syncthreads();
  for (int kt = 0; kt < nk; kt += 2) {
    J_LOAD(ra0, rb0, (kt + 2 < nk ? kt + 2 : nk - 1));
    J_COMPUTE(0);
    if (kt + 1 < nk) J_STORE(ra1, rb1, 1);
    __syncthreads();
    if (kt + 1 < nk) {
      J_LOAD(ra1, rb1, (kt + 3 < nk ? kt + 3 : nk - 1));
      J_COMPUTE(1);
      if (kt + 2 < nk) J_STORE(ra0, rb0, 0);
      __syncthreads();
    }
  }
#undef J_LOAD
#undef J_STORE
#undef J_COMPUTE
}

template <class AP>
DI void gemm_kloop256(f32x16 (&acc)[4][2], const AP& ap, const u16* Bt, long ldb, int K, char* lds, int tid) {
  asm volatile("" : "+v"(tid));
  const int lane = tid & 63, w = tid >> 6, wm = w >> 1, wn = w & 1, r = lane & 31, h = lane >> 5;
  const int lrow = tid >> 2, lk = (tid & 3) * 8;
  const int nk = K >> 5;
#define H_LOAD(RA, RB, KT) { const int k0_ = (KT) * 32 + lk; \
    _Pragma("unroll") for (int i = 0; i < 4; ++i) RA[i] = *(const u32x4*)ap(lrow + 64 * i, k0_); \
    _Pragma("unroll") for (int i = 0; i < 2; ++i) RB[i] = *(const u32x4*)(Bt + (long)(lrow + 64 * i) * ldb + k0_); }
#define H_STORE(RA, RB, BUF) { char* lw_ = lds + (BUF) * 30720; \
    _Pragma("unroll") for (int i = 0; i < 4; ++i) *(u32x4*)(lw_ + (lrow + 64 * i) * 80 + lk * 2) = RA[i]; \
    _Pragma("unroll") for (int i = 0; i < 2; ++i) *(u32x4*)(lw_ + 20480 + (lrow + 64 * i) * 80 + lk * 2) = RB[i]; }
#define H_COMPUTE(BUF) { const char* la_ = lds + (BUF) * 30720 + (wm * 128 + r) * 80 + h * 16; \
    const char* lb_ = lds + (BUF) * 30720 + 20480 + (wn * 64 + r) * 80 + h * 16; \
    _Pragma("unroll") for (int ks = 0; ks < 2; ++ks) { \
      bf16x8 b0 = *(const bf16x8*)(lb_ + ks * 32), b1 = *(const bf16x8*)(lb_ + 32 * 80 + ks * 32); \
      _Pragma("unroll") for (int mi = 0; mi < 4; ++mi) { \
        bf16x8 a_ = *(const bf16x8*)(la_ + mi * 32 * 80 + ks * 32); \
        acc[mi][0] = MFMA(b0, a_, acc[mi][0]); acc[mi][1] = MFMA(b1, a_, acc[mi][1]); } } }
  u32x4 ra0[4], rb0[2], ra1[4], rb1[2];
  H_LOAD(ra0, rb0, 0);
  H_LOAD(ra1, rb1, (nk > 1 ? 1 : 0));
  H_STORE(ra0, rb0, 0);
  __syncthreads();
  for (int kt = 0; kt < nk; kt += 2) {
    H_LOAD(ra0, rb0, (kt + 2 < nk ? kt + 2 : nk - 1));
    H_COMPUTE(0);
    if (kt + 1 < nk) H_STORE(ra1, rb1, 1);
    __syncthreads();
    if (kt + 1 < nk) {
      H_LOAD(ra1, rb1, (kt + 3 < nk ? kt + 3 : nk - 1));
      H_COMPUTE(1);
      if (kt + 2 < nk) H_STORE(ra0, rb0, 0);
      __syncthreads();
    }
  }
#undef H_LOAD
#undef H_STORE
#undef H_COMPUTE
}
#define EPI_M4(mi) (wm * 128 + (mi) * 32 + r)

DI void store_tile256_bf16(const f32x16 (&acc)[4][2], u16* dst, long ldd, char* lds, int tid, u16* halo = nullptr, int grow0 = 0) {
  asm volatile("" : "+v"(tid));
  const int lane = tid & 63, w = tid >> 6, wm = w >> 1, wn = w & 1, r = lane & 31, h = lane >> 5;
#pragma unroll
  for (int mi = 0; mi < 4; ++mi)
#pragma unroll
    for (int ni = 0; ni < 2; ++ni)
#pragma unroll
      for (int a4 = 0; a4 < 4; ++a4) {
        uint2 u; u.x = pk2(acc[mi][ni][4 * a4], acc[mi][ni][4 * a4 + 1]); u.y = pk2(acc[mi][ni][4 * a4 + 2], acc[mi][ni][4 * a4 + 3]);
        *(uint2*)(lds + EPI_M4(mi) * 272 + EPI_N(ni, 4 * a4) * 2) = u;
      }
  __syncthreads();
#pragma unroll
  for (int i = 0; i < 16; ++i) {
    const int c = tid + 256 * i, row = c >> 4, cc = c & 15;
    const u32x4 v = *(const u32x4*)(lds + row * 272 + cc * 16);
    *(u32x4*)(dst + (long)row * ldd + cc * 8) = v;
    if (halo && ((row & 63) >= 61)) {
      const int grow = grow0 + row;
      *(u32x4*)(halo + ((long)(grow >> 6) * 3 + ((grow & 63) - 61)) * 1024 + cc * 8) = v;
    }
  }
  __syncthreads();
}

DI bool tile_xcd(int it, int n_mt, int n_nt, int& mt, int& nt) {
  const int x = blockIdx.x & 7, loc = blockIdx.x >> 3, nloc = gridDim.x >> 3;
  const int rt = n_mt >> 3;
  const int i = loc + it * nloc;
  if (i >= rt * n_nt) return false;
  mt = x * rt + (i % rt); nt = i / rt;
  return true;
}

DI int win_src_col(int n) {
  if (n < 2560) return n;
  if (n < 4096) return n - 2560 + 2608;
  if (n < 4608) return n - 4096 + 4152;
  if (n < 5120) return n - 4608 + 4664;
  if (n < 5248) { int c = n - 5120; if (c < 48) return 2560 + c; if (c < 56) return 4144 + (c - 48); return -1; }
  return n - 5248 + 5176;
}
DI int ff_src_col(int n) { int blk = n >> 6, w = n & 63; return (w < 32) ? (blk * 32 + w) : (2816 + blk * 32 + (w - 32)); }

DI void transpose_tile(const float* src, int Nsrc, u16* dst, int K, int k0, int n0, int map, float* tile, int tid) {
  {
    const int n4 = (tid & 15) * 4, kb = tid >> 4;
    const int n = n0 + n4;
    const int sc = (map == 0) ? n : (map == 1 ? win_src_col(n) : ff_src_col(n));
    float4 v[4];
#pragma unroll
    for (int i = 0; i < 4; ++i) v[i] = (sc >= 0) ? ldnt4(src + (long)(k0 + kb + 16 * i) * Nsrc + sc) : make_float4(0.f, 0.f, 0.f, 0.f);
#pragma unroll
    for (int i = 0; i < 4; ++i) *(float4*)(tile + (kb + 16 * i) * 68 + n4) = v[i];
  }
  __syncthreads();
  {
#pragma unroll
    for (int i = 0; i < 2; ++i) {
      const int item = tid + 256 * i, nn = item & 63, k8 = (item >> 6) * 8;
      float f[8];
#pragma unroll
      for (int j = 0; j < 8; ++j) f[j] = tile[(k8 + j) * 68 + nn];
      u32x4 u;
      u.x = pk2(f[0], f[1]); u.y = pk2(f[2], f[3]); u.z = pk2(f[4], f[5]); u.w = pk2(f[6], f[7]);
      *(u32x4*)(dst + (long)(n0 + nn) * K + k0 + k8) = u;
    }
  }
  __syncthreads();
}

DI void rmsnorm_row_bf16(const float* src, const float* g, u16* dst, int lane) {
  float4 v[4]; float ss = 0.f;
#pragma unroll
  for (int i = 0; i < 4; ++i) { v[i] = ((const float4*)src)[lane + 64 * i]; ss += v[i].x * v[i].x + v[i].y * v[i].y + v[i].z * v[i].z + v[i].w * v[i].w; }
  ss = wave_sum(ss);
  const float rn = rsqrtf(ss * (1.0f / 1024.0f) + 1e-6f);
#pragma unroll
  for (int i = 0; i < 4; ++i) {
    float4 gg = ((const float4*)g)[lane + 64 * i];
    uint2 o; o.x = pk2(v[i].x * rn * gg.x, v[i].y * rn * gg.y); o.y = pk2(v[i].z * rn * gg.z, v[i].w * rn * gg.w);
    ((uint2*)dst)[lane + 64 * i] = o;
  }
}

DI bool transpose_job(const Params& p, int t, int set, float* tile, int tid) {
  int rem = t;
  const float* src = nullptr; u16* dst = nullptr; int Nsrc = 0, K = 0, Nd = 0, map = 0;
  bool found = false;
  for (int j = 0; j < 6; ++j) {
    if (set == 0) {
      if (j >= 4) break;
      switch (j) {
        case 0: src = p.w_in; Nsrc = 8248; dst = p.WinT; K = 1024; Nd = 8320; map = 1; break;
        case 1: src = p.w_mem_kv; Nsrc = 1024; dst = p.WmkvT; K = 1024; Nd = 1024; map = 0; break;
        case 2: src = p.w1_k; Nsrc = 128; dst = p.W1kT; K = 2048; Nd = 128; map = 0; break;
        default: src = p.w1_v; Nsrc = 128; dst = p.W1vT; K = 2048; Nd = 128; map = 0; break;
      }
    } else {
      switch (j) {
        case 0: src = p.w_ffin; Nsrc = 5632; dst = p.WffT; K = 1024; Nd = 5632; map = 2; break;
        case 1: src = p.w_ffdn; Nsrc = 1024; dst = p.WdnT; K = 2816; Nd = 1024; map = 0; break;
        case 2: src = p.w_pn; Nsrc = 1024; dst = p.WpnT; K = 1024; Nd = 1024; map = 0; break;
        case 3: src = p.w_pml; Nsrc = 1024; dst = p.WpmlT; K = 512; Nd = 1024; map = 0; break;
        case 4: src = p.w_pmem; Nsrc = 1024; dst = p.WpmemT; K = 512; Nd = 1024; map = 0; break;
        default: src = p.w_out; Nsrc = 1024; dst = p.WoutT; K = 1024; Nd = 1024; map = 0; break;
      }
    }
    const int nt = (Nd >> 6) * (K >> 6);
    if (rem < nt) { found = true; break; }
    rem -= nt;
  }
  if (!found) return false;
  const int kt = K >> 6;
  transpose_tile(src, Nsrc, dst, K, (rem % kt) * 64, (rem / kt) * 64, map, tile, tid);
  return true;
}

DI void phase_prep(const Params& p, char* lds, int tid) {
  float* tile = (float*)lds;
  if (blockIdx.x == 0 && tid == 0) { int* c_ = p.ctr; asm volatile("" : "+s"(c_)); __hip_atomic_store(c_ + 0, 0, __ATOMIC_RELAXED, __HIP_MEMORY_SCOPE_AGENT); __hip_atomic_store(c_ + 1, 0, __ATOMIC_RELAXED, __HIP_MEMORY_SCOPE_AGENT); __hip_atomic_store(c_ + 2, 0, __ATOMIC_RELAXED, __HIP_MEMORY_SCOPE_AGENT); }
  if (blockIdx.x == 1 && tid < 32) __hip_atomic_store(p.ctr + 32 + tid, 0, __ATOMIC_RELAXED, __HIP_MEMORY_SCOPE_AGENT);
  for (int t = blockIdx.x;; t += gridDim.x) {
    if (!transpose_job(p, t, 0, tile, tid)) break;
  }
  {
    const int lane = tid & 63, w = tid >> 6;
    const int stride = gridDim.x * 4;
    for (int row0 = blockIdx.x * 4 + w; row0 < T_TOK + 2048; row0 += 3 * stride) {
      float4 v[3][4];
#pragma unroll
      for (int k = 0; k < 3; ++k) {
        const int row = (row0 + k * stride < T_TOK + 2048) ? row0 + k * stride : row0;
        const float* sp = (row < T_TOK) ? p.x + (long)row * 1024 : p.mem + (long)(row - T_TOK) * 1024;
#pragma unroll
        for (int i = 0; i < 4; ++i) v[k][i] = ldnt4(sp + 4 * (lane + 64 * i));
      }
#pragma unroll
      for (int k = 0; k < 3; ++k) {
        const int row = row0 + k * stride;
        if (row < T_TOK + 2048) {
          const float* g = (row < T_TOK) ? p.g_pre_mix : p.g_mem;
          u16* dp = (row < T_TOK) ? p.hbuf + (long)row * 1024 : p.memn + (long)(row - T_TOK) * 1024;
          float ss = 0.f;
#pragma unroll
          for (int i = 0; i < 4; ++i) ss += v[k][i].x * v[k][i].x + v[k][i].y * v[k][i].y + v[k][i].z * v[k][i].z + v[k][i].w * v[k][i].w;
          const float rn = rsqrtf(wave_sum(ss) * (1.0f / 1024.0f) + 1e-6f);
#pragma unroll
          for (int i = 0; i < 4; ++i) {
            const float4 gg = ((const float4*)g)[lane + 64 * i];
            uint2 o; o.x = pk2(v[k][i].x * rn * gg.x, v[k][i].y * rn * gg.y); o.y = pk2(v[k][i].z * rn * gg.z, v[k][i].w * rn * gg.w);
            ((uint2*)dp)[lane + 64 * i] = o;
          }
        }
      }
    }
  }
  if (blockIdx.x < 32) {
    const int side = blockIdx.x >> 4, part = blockIdx.x & 15;
    const float* pe = side ? p.pe_v : p.pe_k;
    const float* w1 = side ? p.w1_v : p.w1_k;
    const int hc = tid & 127, half = tid >> 7;
    const int kk0 = part * 128 + half * 64;
    float s = 0.f;
#pragma unroll 16
    for (int kk = kk0; kk < kk0 + 64; ++kk) s += pe[kk] * w1[(long)kk * 128 + hc];
    __syncthreads();
    tile[tid] = s;
    __syncthreads();
    if (tid < 128) p.cbias[256 + (side * 16 + part) * 128 + tid] = tile[tid] + tile[tid + 128];
    __syncthreads();
  }
}

DI void phase_gemm_in(const Params& p, char* lds, int tid) {
  if (blockIdx.x == gridDim.x - 1) {
    const int side = tid >> 7, hc = tid & 127;
    float s = 0.f;
    for (int part = 0; part < 16; ++part) s += p.cbias[256 + (side * 16 + part) * 128 + hc];
    p.cbias[tid] = s;
  }
  for (int it = 0;; ++it) {
    int mt, nt;
    if (!tile_xcd(it, 128, 41, mt, nt)) break;
    f32x16 acc[2][2];
    for (int a = 0; a < 2; ++a) for (int b = 0; b < 2; ++b) acc[a][b] = zero16();
    gemm_kloop(acc, APlain{p.hbuf + (long)mt * 128 * 1024, 1024}, p.WinT + (long)nt * 128 * 1024, 1024, 1024, lds, tid);
    const long m0 = (long)mt * 128;
    if (nt < 40) {
      store_tile_bf16(acc, p.z + m0 * ZW + nt * 128, ZW, lds, tid, (nt >= 20 && nt < 28) ? p.halo + (nt - 20) * 128 : nullptr, (int)m0);
    } else {
      int t3 = tid;
      asm volatile("" : "+v"(t3));
      const int wm = (t3 >> 7) & 1, wn = (t3 >> 6) & 1, r = t3 & 31, h = (t3 >> 5) & 1;
      float* gl = (float*)lds;
      if (wn == 0) {
#pragma unroll
        for (int mi = 0; mi < 2; ++mi)
#pragma unroll
          for (int ni = 0; ni < 2; ++ni)
#pragma unroll
            for (int a4 = 0; a4 < 4; ++a4) {
              const float4 v4 = make_float4(acc[mi][ni][4 * a4], acc[mi][ni][4 * a4 + 1], acc[mi][ni][4 * a4 + 2], acc[mi][ni][4 * a4 + 3]);
              *(float4*)(p.zf + (m0 + EPI_M(mi)) * 64 + EPI_N(ni, 4 * a4)) = v4;
              if (ni == 1 && a4 == 2) *(float4*)(gl + EPI_M(mi) * 8 + 4 * h) = v4;
            }
      }
      __syncthreads();
      {
        const int lane2 = t3 & 63, w2 = t3 >> 6;
        const int crow0 = (w2 >> 1) * 64;
        const long grow = m0 + crow0;
        const int bb = (int)(grow >> 11), cc = (int)((grow & 2047) >> 6);
#pragma unroll
        for (int hq = 0; hq < 2; ++hq) {
          const int hh = (w2 & 1) * 2 + hq;
          const float ig = gl[(crow0 + lane2) * 8 + hh] + p.gate_b[hh], fg = gl[(crow0 + lane2) * 8 + 4 + hh] + p.gate_b[4 + hh];
          const float lf = fminf(fg, 0.f) - log1pf(__expf(-fabsf(fg)));
          float bs = lf;
#pragma unroll
          for (int o = 1; o < 64; o <<= 1) { const float t = __shfl_up(bs, o); if (lane2 >= o) bs += t; }
          float cm = ig - bs;
#pragma unroll
          for (int o = 1; o < 64; o <<= 1) { const float t = __shfl_up(cm, o); if (lane2 >= o) cm = fmaxf(cm, t); }
          if (lane2 == 63) { const int task = (bb * 4 + hh) * 32 + cc; p.mlba[task * 2] = bs; p.mlba[task * 2 + 1] = cm; }
        }
      }
      __syncthreads();
    }
  }
  {
    const int xg = blockIdx.x & 7, loc = blockIdx.x >> 3, nloc = gridDim.x >> 3;
    const bool spread = nloc >= 32;
    for (int t = spread ? ((loc >= 16 && loc < 32) ? xg * 16 + (loc - 16) : 128) : (int)blockIdx.x; t < 128; t += spread ? 128 : (int)gridDim.x) {
      const int mt = t >> 3, nt = t & 7;
      f32x16 acc[2][2];
      for (int a = 0; a < 2; ++a) for (int b = 0; b < 2; ++b) acc[a][b] = zero16();
      gemm_kloop(acc, APlain{p.memn + (long)mt * 128 * 1024, 1024}, p.WmkvT + (long)nt * 128 * 1024, 1024, 1024, lds, tid);
      store_tile_bf16(acc, p.kvm + (long)mt * 128 * 1024 + nt * 128, 1024, lds, tid);
    }
  }
  {
    int* sh_item = (int*)(lds + LDS_BYTES + 32);
    while (true) {
      if (tid == 0) *sh_item = atomicAdd(p.ctr + 2, 1);
      __syncthreads();
      const int t = *sh_item;
      __syncthreads();
      if (!transpose_job(p, t, 1, (float*)lds, tid)) break;
    }
  }
}

DI void compress_item(const Params& p, int it, char* lds, int tid) {
  const int lane = tid & 63, w = tid >> 6, wm = w >> 1, wn = w & 1, r = lane & 31, h = lane >> 5;
  const int side = it >> 6, b = (it >> 3) & 7, rt = it & 7;
  f32x16 acc[2];
  acc[0] = zero16(); acc[1] = zero16();
  ACmp ap{p.z + (long)b * 2048 * ZW + 1024 + side * 256, rt * 64};
  gemm_kloop64(acc, ap, side ? p.W1vT : p.W1kT, 2048, 2048, lds, tid);
  u16* hid = (u16*)lds;
  float* w2s = (float*)(lds + 17408);
  const float* cb = p.cbias + side * 128;
#pragma unroll
  for (int ni = 0; ni < 2; ++ni)
#pragma unroll
    for (int a4 = 0; a4 < 4; ++a4) {
      const float4 bb = *(const float4*)(cb + EPI_N(ni, 4 * a4));
      uint2 u;
      u.x = pk2(siluf_(acc[ni][4 * a4] + bb.x), siluf_(acc[ni][4 * a4 + 1] + bb.y));
      u.y = pk2(siluf_(acc[ni][4 * a4 + 2] + bb.z), siluf_(acc[ni][4 * a4 + 3] + bb.w));
      *(uint2*)(hid + (wm * 32 + r) * 136 + EPI_N(ni, 4 * a4)) = u;
    }
  const float* w2 = side ? p.w2_v : p.w2_k;
  for (int i = tid; i < 2048; i += 256) ((float4*)w2s)[i] = ((const float4*)w2)[i];
  __syncthreads();
  {
    const int row = tid >> 2, dh0 = (tid & 3) * 16;
    float o[16];
#pragma unroll
    for (int d = 0; d < 16; ++d) o[d] = 0.f;
#pragma unroll 4
    for (int hh = 0; hh < 128; ++hh) {
      const float hv = bf2f(hid[row * 136 + hh]);
      const float4* wr = (const float4*)(w2s + hh * 64 + dh0);
#pragma unroll
      for (int d4 = 0; d4 < 4; ++d4) { float4 ww = wr[d4]; o[4 * d4] += hv * ww.x; o[4 * d4 + 1] += hv * ww.y; o[4 * d4 + 2] += hv * ww.z; o[4 * d4 + 3] += hv * ww.w; }
    }
    const int rg = rt * 64 + row, n = rg >> 2, g = rg & 3;
    const float keep = (n < 127) ? 1.f : 0.f;
    u16* dst = (side ? p.vc : p.kc) + ((long)((b * 4 + g) * 128 + n)) * 64 + dh0;
#pragma unroll
    for (int d8 = 0; d8 < 2; ++d8) {
      u32x4 u;
      u.x = pk2(o[8 * d8] * keep, o[8 * d8 + 1] * keep); u.y = pk2(o[8 * d8 + 2] * keep, o[8 * d8 + 3] * keep);
      u.z = pk2(o[8 * d8 + 4] * keep, o[8 * d8 + 5] * keep); u.w = pk2(o[8 * d8 + 6] * keep, o[8 * d8 + 7] * keep);
      ((u32x4*)dst)[d8] = u;
    }
  }
  __syncthreads();
}

template <int NE> struct AttnState { f32x16 o[NE]; float m, l; };
template <int NE> DI void attn_init(AttnState<NE>& st) {
#pragma unroll
  for (int e = 0; e < NE; ++e) st.o[e] = zero16();
  st.m = -1e30f; st.l = 0.f;
}

template <int DH, bool EMIT, int NE, int E0, class MF>
DI void attn_sweep(AttnState<NE>& st, const bf16x8 (&qf)[DH / 16], const u16* Kb, const u16* Vb, long stride, int t_first, int t_last,
                   unsigned tmask, float sc, MF mf, char* lds, int tid, float* psum, float il) {
  constexpr int STR = (DH + 8) * 2;
  constexpr int TB = 64 * STR;
  constexpr int NCH = DH / 32;
  constexpr int CPR = DH / 8;
  const int lane = tid & 63, w = tid >> 6, r = lane & 31, h = lane >> 5;
  const int i16 = lane & 15, tq = i16 >> 2, tp = i16 & 3, blk = (lane >> 4) & 1;
  asm volatile("" : "+s"(t_last));
  int j = t_first;
  while (j <= t_last && !((tmask >> j) & 1u)) ++j;
  if (j > t_last) return;
  u32x4 kr[NCH], vr[NCH];
#pragma unroll
  for (int i = 0; i < NCH; ++i) {
    const int c = tid + 256 * i, row = c / CPR, cc = c % CPR;
    const long off = (long)(j * 64 + row) * stride + cc * 8;
    kr[i] = *(const u32x4*)(Kb + off);
    if (!EMIT) vr[i] = *(const u32x4*)(Vb + off);
  }
  int buf = 0;
  while (true) {
    {
      char* base = lds + buf * 2 * TB;
#pragma unroll
      for (int i = 0; i < NCH; ++i) {
        const int c = tid + 256 * i, row = c / CPR, cc = c % CPR;
        *(u32x4*)(base + row * STR + cc * 16) = kr[i];
        if (!EMIT) *(u32x4*)(base + TB + row * STR + cc * 16) = vr[i];
      }
    }
    __syncthreads();
    int jn = j + 1;
    while (jn <= t_last && !((tmask >> jn) & 1u)) ++jn;
    if (true) {
      const int jl = (jn <= t_last) ? jn : j;
#pragma unroll
      for (int i = 0; i < NCH; ++i) {
        const int c = tid + 256 * i, row = c / CPR, cc = c % CPR;
        const long off = (long)(jl * 64 + row) * stride + cc * 8;
        kr[i] = *(const u32x4*)(Kb + off);
        if (!EMIT) vr[i] = *(const u32x4*)(Vb + off);
      }
    }
    const char* kl = lds + buf * 2 * TB;
    const char* vl = kl + TB;
    f32x16 s[2];
#pragma unroll
    for (int mt = 0; mt < 2; ++mt) {
      s[mt] = zero16();
#pragma unroll
      for (int ks = 0; ks < DH / 16; ++ks) {
        bf16x8 a = *(const bf16x8*)(kl + (32 * mt + r) * STR + (16 * ks + 8 * h) * 2);
        s[mt] = MFMA(a, qf[ks], s[mt]);
      }
    }
    const int kbase = j * 64;
    if (!EMIT) {
      float mx = -3.0e38f;
#pragma unroll
      for (int mt = 0; mt < 2; ++mt)
#pragma unroll
        for (int i = 0; i < 16; ++i) {
          const int key = kbase + 32 * mt + (i & 3) + 8 * (i >> 2) + 4 * h;
          const float v = mf(key) ? s[mt][i] * sc : -INFINITY;
          s[mt][i] = v; mx = fmaxf(mx, v);
        }
      mx = fmaxf(mx, __shfl_xor(mx, 32));
      const float m_new = fmaxf(st.m, mx);
      const float alpha = ex2(st.m - m_new);
      float rs = 0.f;
#pragma unroll
      for (int mt = 0; mt < 2; ++mt)
#pragma unroll
        for (int i = 0; i < 16; ++i) { const float pv = ex2(s[mt][i] - m_new); s[mt][i] = pv; rs += pv; }
      rs += __shfl_xor(rs, 32);
      st.l = st.l * alpha + rs; st.m = m_new;
#pragma unroll
      for (int e = 0; e < NE; ++e)
#pragma unroll
        for (int i = 0; i < 16; ++i) st.o[e][i] *= alpha;
      bf16x8 pf[2][2];
#pragma unroll
      for (int mt = 0; mt < 2; ++mt) { pf[mt][0] = pack8(s[mt], 0); pf[mt][1] = pack8(s[mt], 1); }
#pragma unroll
      for (int e = 0; e < NE; ++e)
#pragma unroll
        for (int mt = 0; mt < 2; ++mt)
#pragma unroll
          for (int s2 = 0; s2 < 2; ++s2) {
            const char* vp = vl + (32 * mt + 16 * s2 + 4 * h + tq) * STR + (32 * (e + E0) + 16 * blk + 4 * tp) * 2;
            bf16x8 a = tr_pair(vp, 8 * STR);
            st.o[e] = MFMA(a, pf[mt][s2], st.o[e]);
          }
    } else {
#pragma unroll
      for (int mt = 0; mt < 2; ++mt)
#pragma unroll
        for (int i = 0; i < 16; ++i) {
          const int key = kbase + 32 * mt + (i & 3) + 8 * (i >> 2) + 4 * h;
          s[mt][i] = mf(key) ? ex2(s[mt][i] * sc - st.m) * il : 0.f;
        }
      for (int ww = 0; ww < 4; ++ww) {
        if (w == ww) {
#pragma unroll
          for (int mt = 0; mt < 2; ++mt)
#pragma unroll
            for (int a4 = 0; a4 < 4; ++a4) {
              float4* pp = (float4*)(psum + r * 132 + kbase + 32 * mt + 8 * a4 + 4 * h);
              float4 v = *pp;
              v.x += s[mt][4 * a4]; v.y += s[mt][4 * a4 + 1]; v.z += s[mt][4 * a4 + 2]; v.w += s[mt][4 * a4 + 3];
              *pp = v;
            }
        }
        __syncthreads();
      }
    }
    if (jn > t_last) break;
    j = jn; buf ^= 1;
    if (false) {
#pragma unroll
      for (int i = 0; i < NCH; ++i) {
        const int c = tid + 256 * i, row = c / CPR, cc = c % CPR;
        const long off = (long)(j * 64 + row) * stride + cc * 8;
        kr[i] = *(const u32x4*)(Kb + off);
        if (!EMIT) vr[i] = *(const u32x4*)(Vb + off);
      }
    }
  }
  __syncthreads();
}

struct MaskSlc { int tq, qblk; unsigned mask;
  DI bool need_elem(int j) const { return j == qblk; }
  DI bool row_ok(int j) const { return (mask >> j) & 1u; }
  DI bool elem_ok(int pos) const { return ((mask >> (pos >> 6)) & 1u) && (pos <= tq); } };
struct MaskWin { int tq, qblk, t0;
  DI bool need_elem(int j) const { return (j == qblk) || (64 * j < t0 - 480); }
  DI bool row_ok(int) const { return true; }
  DI bool elem_ok(int pos) const { return (pos <= tq) && (pos > tq - 512); } };
typedef float f32x2 __attribute__((ext_vector_type(2)));

template <class MF>
DI void attn_sweep_pf2(AttnState<2>& st, const bf16x8 (&qf)[4], const u16* Kb, const u16* Vb, long stride, int t_first, int t_last,
                       unsigned tmask, float sc, MF mf, char* lds, int tid) {
  constexpr int STR = 144, TB = 64 * STR;
  const int lane = tid & 63, r = lane & 31, h = lane >> 5;
  const int i16 = lane & 15, tq = i16 >> 2, tp = i16 & 3, blk = (lane >> 4) & 1;
  asm volatile("" : "+s"(t_last));
  const int lrow0 = tid >> 3, lcc = tid & 7;
  auto next_active = [&](int j) { while (j <= t_last && !((tmask >> j) & 1u)) ++j; return j; };
  int cur = next_active(t_first);
  if (cur > t_last) return;
  int nxt = next_active(cur + 1);
  u32x4 k0[2], v0[2];
#define A_LOAD(KR, VR, JT) { _Pragma("unroll") for (int i = 0; i < 2; ++i) { const long off_ = (long)((JT) * 64 + lrow0 + 32 * i) * stride + lcc * 8; \
      KR[i] = *(const u32x4*)(Kb + off_); VR[i] = *(const u32x4*)(Vb + off_); } }
#define A_STORE(KR, VR, BUF) { char* base_ = lds + (BUF) * 2 * TB; _Pragma("unroll") for (int i = 0; i < 2; ++i) { \
      *(u32x4*)(base_ + (lrow0 + 32 * i) * STR + lcc * 16) = KR[i]; *(u32x4*)(base_ + TB + (lrow0 + 32 * i) * STR + lcc * 16) = VR[i]; } }
  auto compute = [&](int j, int bufi) __attribute__((always_inline)) {
    const char* kl = lds + bufi * 2 * TB;
    const char* vl = kl + TB;
    f32x16 s[2];
#pragma unroll
    for (int mt = 0; mt < 2; ++mt) {
      s[mt] = zero16();
#pragma unroll
      for (int ks = 0; ks < 4; ++ks) {
        bf16x8 a = *(const bf16x8*)(kl + (32 * mt + r) * STR + (16 * ks + 8 * h) * 2);
        s[mt] = MFMA(a, qf[ks], s[mt]);
      }
    }
    const int kbase = j * 64;
    float m_new, alpha, rs;
    if (mf.need_elem(j)) {
      float mx = -3.0e38f;
#pragma unroll
      for (int mt = 0; mt < 2; ++mt)
#pragma unroll
        for (int i = 0; i < 16; ++i) {
          const int key = kbase + 32 * mt + (i & 3) + 8 * (i >> 2) + 4 * h;
          const float v = mf.elem_ok(key) ? s[mt][i] * sc : -INFINITY;
          s[mt][i] = v; mx = fmaxf(mx, v);
        }
      mx = fmaxf(mx, __shfl_xor(mx, 32));
      m_new = fmaxf(st.m, mx);
      alpha = ex2(st.m - m_new);
      rs = 0.f;
#pragma unroll
      for (int mt = 0; mt < 2; ++mt)
#pragma unroll
        for (int i = 0; i < 16; ++i) { const float pv = ex2(s[mt][i] - m_new); s[mt][i] = pv; rs += pv; }
    } else {
      const bool rok = mf.row_ok(j);
      float mr = fmaxf(s[0][0], s[1][0]);
#pragma unroll
      for (int i = 1; i < 16; ++i) mr = fmaxf(fmaxf(mr, s[0][i]), s[1][i]);
      mr = fmaxf(mr, __shfl_xor(mr, 32));
      const float mx = rok ? mr * sc : -INFINITY;
      m_new = fmaxf(st.m, mx);
      alpha = ex2(st.m - m_new);
      const float scl = rok ? sc : 0.f, off = rok ? -m_new : -INFINITY;
      f32x2 rs2 = {0.f, 0.f};
#pragma unroll
      for (int mt = 0; mt < 2; ++mt)
#pragma unroll
        for (int i2 = 0; i2 < 8; ++i2) {
          f32x2 v = {s[mt][2 * i2], s[mt][2 * i2 + 1]};
          v = v * scl + off;
          v.x = ex2(v.x); v.y = ex2(v.y);
          s[mt][2 * i2] = v.x; s[mt][2 * i2 + 1] = v.y;
          rs2 += v;
        }
      rs = rs2.x + rs2.y;
    }
    rs += __shfl_xor(rs, 32);
    st.l = st.l * alpha + rs; st.m = m_new;
#pragma unroll
    for (int e = 0; e < 2; ++e)
#pragma unroll
      for (int i2 = 0; i2 < 8; ++i2) {
        f32x2 ov = {st.o[e][2 * i2], st.o[e][2 * i2 + 1]};
        ov = ov * alpha;
        st.o[e][2 * i2] = ov.x; st.o[e][2 * i2 + 1] = ov.y;
      }
    bf16x8 pf[2][2];
#pragma unroll
    for (int mt = 0; mt < 2; ++mt) { pf[mt][0] = pack8(s[mt], 0); pf[mt][1] = pack8(s[mt], 1); }
#pragma unroll
    for (int e = 0; e < 2; ++e)
#pragma unroll
      for (int mt = 0; mt < 2; ++mt)
#pragma unroll
        for (int s2 = 0; s2 < 2; ++s2) {
          const char* vp = vl + (32 * mt + 16 * s2 + 4 * h + tq) * STR + (32 * e + 16 * blk + 4 * tp) * 2;
          bf16x8 a = tr_pair(vp, 8 * STR);
          st.o[e] = MFMA(a, pf[mt][s2], st.o[e]);
        }
  };
  A_LOAD(k0, v0, cur);
  int bufi = 0;
  while (true) {
    A_STORE(k0, v0, bufi);
    __syncthreads();
    const int nn = (nxt <= t_last) ? next_active(nxt + 1) : nxt;
    A_LOAD(k0, v0, (nxt <= t_last ? nxt : cur));
    compute(cur, bufi);
    if (nxt > t_last) break;
    cur = nxt; nxt = nn; bufi ^= 1;
  }
#undef A_LOAD
#undef A_STORE
  __syncthreads();
}

DI void nsa_item(const Params& p, int b, int g, int qt, char* lds, int tid) {
  const int lane = tid & 63, w = tid >> 6, r = lane & 31, h = lane >> 5;
  const int t0 = qt * 32, qblk = t0 >> 6, tqry = t0 + r;
  const long tok = (long)b * 2048 + tqry;
  const int head = g * 4 + w;
  float* psum = (float*)(lds + 36864);
  float* impv = (float*)(lds + 36864 + 16896);
  unsigned* selm = (unsigned*)(lds + 36864 + 16896 + 4224);
  for (int i = tid; i < 32 * 132; i += 256) psum[i] = 0.f;
  if (tid < 32) selm[tid] = 0u;
  bf16x8 qf[4];
  {
    const u16* qp = p.z + tok * ZW + head * 64 + 8 * h;
#pragma unroll
    for (int ks = 0; ks < 4; ++ks) qf[ks] = *(const bf16x8*)(qp + 16 * ks);
  }
  const float* gp = p.zf + tok * 64 + head * 3;
  const float g0 = sigmoidf_(gp[0]), g1 = sigmoidf_(gp[1]), g2 = sigmoidf_(gp[2]);
  const float sc = 0.125f * 1.4426950408889634f;
  unsigned ypk[2][8];
#pragma unroll
  for (int e = 0; e < 2; ++e)
#pragma unroll
    for (int i = 0; i < 8; ++i) ypk[e][i] = 0u;
  AttnState<2> st;
  const u16* kcb = p.kc + (long)(b * 4 + g) * 128 * 64;
  const u16* vcb = p.vc + (long)(b * 4 + g) * 128 * 64;
  auto mf_cmp = [&](int n) { return 16 * n + 31 <= tqry; };
  attn_init(st);
  attn_sweep<64, false, 2, 0>(st, qf, kcb, vcb, 64, 0, 1, 0xffffffffu, sc, mf_cmp, lds, tid, nullptr, 0.f);
  {
    const float il = st.l > 0.f ? 1.0f / st.l : 0.f;
    const float f = g0 * il;
#pragma unroll
    for (int e = 0; e < 2; ++e)
#pragma unroll
      for (int i = 0; i < 8; ++i) ypk[e][i] = pk2(bflo(ypk[e][i]) + f * st.o[e][2 * i], bfhi(ypk[e][i]) + f * st.o[e][2 * i + 1]);
    if (qblk >= 16) attn_sweep<64, true, 2, 0>(st, qf, kcb, vcb, 64, 0, 1, 0xffffffffu, sc, mf_cmp, lds, tid, psum, il);
  }
  unsigned mymask;
  if (qblk >= 16) {
    __syncthreads();
    {
      const int qq = tid >> 3, jb = (tid & 7) * 4;
      const float* P = psum + qq * 132;
#pragma unroll
      for (int jj = 0; jj < 4; ++jj) {
        const int j = jb + jj;
        float v = P[4 * j] + P[4 * j + 1] + P[4 * j + 2] + 0.5f * P[4 * j + 3];
        if (j > 0) v += 0.5f * P[4 * j - 1];
        impv[qq * 33 + j] = v;
      }
    }
    __syncthreads();
    {
      const int qq = tid >> 3, jb = (tid & 7) * 4;
      const float* I = impv + qq * 33;
      const int hi = qblk - 2;
      unsigned bits = 0u;
      for (int jj = 0; jj < 4; ++jj) {
        const int j = jb + jj;
        if (j >= 1 && j <= hi) {
          const float v = I[j];
          int rank = 0;
          for (int i = 1; i <= hi; ++i) { const float u = I[i]; rank += ((u > v) || (u == v && i < j)) ? 1 : 0; }
          if (rank < 13) bits |= (1u << j);
        }
      }
      if (bits) atomicOr(&selm[qq], bits);
    }
    __syncthreads();
    mymask = selm[r] | 1u | (1u << (qblk - 1)) | (1u << qblk);
  } else {
    mymask = (2u << qblk) - 1u;
  }
  unsigned um = mymask;
  for (int o = 16; o >= 1; o >>= 1) um |= __shfl_xor(um, o);
  um = __builtin_amdgcn_readfirstlane(um);
  {
    const u16* kb = p.z + (long)b * 2048 * ZW + 1024 + 2 * 256 + g * 64;
    const u16* vb = kb + 256;
    const MaskSlc mf{tqry, qblk, mymask};
    attn_init(st);
    attn_sweep_pf2(st, qf, kb, vb, ZW, 0, qblk, um, sc, mf, lds, tid);
    const float f = g1 * (st.l > 0.f ? 1.0f / st.l : 0.f);
#pragma unroll
    for (int e = 0; e < 2; ++e)
#pragma unroll
      for (int i = 0; i < 8; ++i) ypk[e][i] = pk2(bflo(ypk[e][i]) + f * st.o[e][2 * i], bfhi(ypk[e][i]) + f * st.o[e][2 * i + 1]);
  }
  {
    const u16* kb = p.z + (long)b * 2048 * ZW + 1024 + 4 * 256 + g * 64;
    const u16* vb = kb + 256;
    const MaskWin mf{tqry, qblk, t0};
    const int lo = t0 - 511;
    attn_init(st);
    attn_sweep_pf2(st, qf, kb, vb, ZW, (lo > 0 ? lo : 0) >> 6, qblk, 0xffffffffu, sc, mf, lds, tid);
    const float f = g2 * (st.l > 0.f ? 1.0f / st.l : 0.f);
#pragma unroll
    for (int e = 0; e < 2; ++e)
#pragma unroll
      for (int i = 0; i < 8; ++i) ypk[e][i] = pk2(bflo(ypk[e][i]) + f * st.o[e][2 * i], bfhi(ypk[e][i]) + f * st.o[e][2 * i + 1]);
  }
  u16* yc = (u16*)p.out + tok * 2048 + head * 64;
#pragma unroll
  for (int e = 0; e < 2; ++e)
#pragma unroll
    for (int a4 = 0; a4 < 4; ++a4) {
      uint2 u; u.x = ypk[e][2 * a4]; u.y = ypk[e][2 * a4 + 1];
      *(uint2*)(yc + 32 * e + 8 * a4 + 4 * h) = u;
    }
}

DI void mem_item(const Params& p, int b, int mh, int qtile, char* lds, int tid) {
  const int lane = tid & 63, w = tid >> 6, r = lane & 31, h = lane >> 5;
  const long tok = (long)b * 2048 + qtile * 128 + 32 * w + r;
  bf16x8 qf[8];
  {
    const u16* qp = p.z + tok * ZW + 4608 + mh * 128 + 8 * h;
#pragma unroll
    for (int ks = 0; ks < 8; ++ks) qf[ks] = *(const bf16x8*)(qp + 16 * ks);
  }
  const u16* kb = p.kvm + (long)b * 256 * 1024 + mh * 128;
  const u16* vb = kb + 512;
  const float sc = 0.08838834764831845f * 1.4426950408889634f;
  u16* yc = (u16*)p.out + tok * 2048 + 1536 + mh * 128;
  {
    AttnState<4> st;
    attn_init(st);
    attn_sweep<128, false, 4, 0>(st, qf, kb, vb, 1024, 0, 3, 0xffffffffu, sc, [](int) { return true; }, lds, tid, nullptr, 0.f);
    const float il = st.l > 0.f ? 1.0f / st.l : 0.f;
#pragma unroll
    for (int e = 0; e < 4; ++e)
#pragma unroll
      for (int a4 = 0; a4 < 4; ++a4) {
        uint2 u; u.x = pk2(st.o[e][4 * a4] * il, st.o[e][4 * a4 + 1] * il); u.y = pk2(st.o[e][4 * a4 + 2] * il, st.o[e][4 * a4 + 3] * il);
        *(uint2*)(yc + 32 * e + 8 * a4 + 4 * h) = u;
      }
  }
}

DI void conv_silu_4tok(const u16* zcol, const u16* hcol, bool first, const float* cw, const float* cb, float scale, char* dst, int tk0, int dc) {
  u32x4 raw[7];
#pragma unroll
  for (int i = 0; i < 7; ++i) {
    const bool inchunk = (tk0 - 3 + i) >= 0;
    const u16* ptr = inchunk ? (zcol + (long)(i - 3) * ZW) : (hcol + (i < 3 ? i : 0) * 1024);
    const u32x4 v = *(const u32x4*)ptr;
    raw[i] = (inchunk || !first) ? v : (u32x4){0u, 0u, 0u, 0u};
  }
  float wv[4][8], bv[8];
#pragma unroll
  for (int t = 0; t < 4; ++t) {
    float4 a = *(const float4*)(cw + t * 1024), b = *(const float4*)(cw + t * 1024 + 4);
    wv[t][0] = a.x; wv[t][1] = a.y; wv[t][2] = a.z; wv[t][3] = a.w; wv[t][4] = b.x; wv[t][5] = b.y; wv[t][6] = b.z; wv[t][7] = b.w;
  }
  { float4 a = *(const float4*)cb, b = *(const float4*)(cb + 4); bv[0] = a.x; bv[1] = a.y; bv[2] = a.z; bv[3] = a.w; bv[4] = b.x; bv[5] = b.y; bv[6] = b.z; bv[7] = b.w; }
#pragma unroll
  for (int o = 0; o < 4; ++o) {
    float acc[8];
#pragma unroll
    for (int e = 0; e < 8; ++e) acc[e] = bv[e];
#pragma unroll
    for (int t = 0; t < 4; ++t) {
      const u32x4 rr = raw[o + t];
      acc[0] += wv[t][0] * bflo(rr.x); acc[1] += wv[t][1] * bfhi(rr.x);
      acc[2] += wv[t][2] * bflo(rr.y); acc[3] += wv[t][3] * bfhi(rr.y);
      acc[4] += wv[t][4] * bflo(rr.z); acc[5] += wv[t][5] * bfhi(rr.z);
      acc[6] += wv[t][6] * bflo(rr.w); acc[7] += wv[t][7] * bfhi(rr.w);
    }
    uint4 u;
    u.x = pk2(siluf_(acc[0]) * scale, siluf_(acc[1]) * scale); u.y = pk2(siluf_(acc[2]) * scale, siluf_(acc[3]) * scale);
    u.z = pk2(siluf_(acc[4]) * scale, siluf_(acc[5]) * scale); u.w = pk2(siluf_(acc[6]) * scale, siluf_(acc[7]) * scale);
    *(uint4*)(dst + (tk0 + o) * 272 + dc * 2) = u;
  }
}

DI void phase_ml_summaries(const Params& p, int tid) {
  const int lane = tid & 63, w = tid >> 6;
  for (int task = blockIdx.x * 4 + w; task < 1024; task += gridDim.x * 4) {
    const int bh = task >> 5, c = task & 31, b = bh >> 2, hh = bh & 3;
    const float* zfp = p.zf + ((long)b * 2048 + c * 64 + lane) * 64;
    const float ig = zfp[48 + hh] + p.gate_b[hh], fg = zfp[52 + hh] + p.gate_b[4 + hh];
    const float lf = fminf(fg, 0.f) - log1pf(__expf(-fabsf(fg)));
    float bs = lf;
#pragma unroll
    for (int o = 1; o < 64; o <<= 1) { const float t = __shfl_up(bs, o); if (lane >= o) bs += t; }
    float cm = ig - bs;
#pragma unroll
    for (int o = 1; o < 64; o <<= 1) { const float t = __shfl_up(cm, o); if (lane >= o) cm = fmaxf(cm, t); }
    if (lane == 63) { p.mlba[task * 2] = bs; p.mlba[task * 2 + 1] = cm; }
  }
}

DI void mlpre_item(const Params& p, int b, int hh, int j, char* lds, int tid) {
  const int lane = tid & 63, w = tid >> 6, r = lane & 31, h = lane >> 5;
  const int i16 = lane & 15, tq = i16 >> 2, tp = i16 & 3, blk = (lane >> 4) & 1;
  constexpr int STR = 272;
  char* Ql = lds; char* Kl = lds + 17408; char* Vl = lds + 34816; char* SQ = lds + 52224;
  float* fa = (float*)(lds + 61440);
  float* fM = fa + 64; float* fb = fM + 64; float* denp = fb + 64;   float* misc = denp + 128;
  const int tc0 = j * 64;
  const long tokb = (long)b * 2048 + tc0;
  float* sc = p.mlsc + (long)((b * 4 + hh) * 32 + j) * 320;
  if (w == 0) {
    const float* ba = p.mlba + (long)((b * 4 + hh) * 32) * 2;
    const float2 mine = (lane < j) ? *(const float2*)(ba + 2 * lane) : make_float2(0.f, 0.f);
    float m_prev = 0.f;
    for (int c = 0; c < j; ++c) {
      const float Bc = __shfl(mine.x, c), Ac = __shfl(mine.y, c);
      m_prev = Bc + fmaxf(m_prev, Ac);
    }
    const float* zfp = p.zf + (tokb + lane) * 64;
    const float ig = zfp[48 + hh] + p.gate_b[hh], fg = zfp[52 + hh] + p.gate_b[4 + hh];
    const float lf = fminf(fg, 0.f) - log1pf(__expf(-fabsf(fg)));
    float bs = lf;
#pragma unroll
    for (int o = 1; o < 64; o <<= 1) { const float t = __shfl_up(bs, o); if (lane >= o) bs += t; }
    const float a = ig - bs;
    float cm = a;
#pragma unroll
    for (int o = 1; o < 64; o <<= 1) { const float t = __shfl_up(cm, o); if (lane >= o) cm = fmaxf(cm, t); }
    const float M = fmaxf(m_prev, cm);
    fa[lane] = a; fM[lane] = M; fb[lane] = bs;
    const float M63 = __shfl(M, 63);
    sc[lane] = __expf(m_prev - M);
    sc[64 + lane] = __expf(-(bs + M));
    sc[192 + lane] = __expf(a - M63);
    if (lane == 0) { sc[256] = __expf(m_prev - M63); misc[0] = M63; }
  }
  {
    const int dc = (tid & 15) * 8, tk0 = (tid >> 4) * 4;
    const u16* zq = p.z + (tokb + tk0) * ZW + 2560 + hh * 128 + dc;
    const u16* hq = p.halo + ((long)(b * 32 + (j > 0 ? j - 1 : 0)) * 3) * 1024 + hh * 128 + dc;
    conv_silu_4tok(zq, hq, j == 0, p.conv_w + hh * 128 + dc, p.conv_b + hh * 128 + dc, 1.0f, Ql, tk0, dc);
    asm volatile("" ::: "memory");
    conv_silu_4tok(zq + 512, hq + 512, j == 0, p.conv_w + 512 + hh * 128 + dc, p.conv_b + 512 + hh * 128 + dc, 0.08838834764831845f, Kl, tk0, dc);
#pragma unroll
    for (int o = 0; o < 4; ++o) *(u32x4*)(Vl + (tk0 + o) * STR + dc * 2) = *(const u32x4*)(zq + 1024 + (long)o * ZW);
  }
  __syncthreads();
  if (w < 3) {
    const int st_ = (w == 2) ? 1 : 0, tt = (w >= 1) ? 1 : 0;
    f32x16 acc = zero16();
#pragma unroll
    for (int ks = 0; ks < 8; ++ks) {
      bf16x8 a = *(const bf16x8*)(Kl + (32 * st_ + r) * STR + (16 * ks + 8 * h) * 2);
      bf16x8 bq = *(const bf16x8*)(Ql + (32 * tt + r) * STR + (16 * ks + 8 * h) * 2);
      acc = MFMA(a, bq, acc);
    }
    const int tI = 32 * tt + r;
    const float Mt = fM[tI];
    float dsum = 0.f;
#pragma unroll
    for (int a4 = 0; a4 < 4; ++a4) {
      float v[4];
#pragma unroll
      for (int jj = 0; jj < 4; ++jj) {
        const int sI = 32 * st_ + 8 * a4 + 4 * h + jj;
        const float e = __expf(fa[sI] - Mt);
        v[jj] = (sI <= tI) ? acc[4 * a4 + jj] * e : 0.f;
        dsum += v[jj];
      }
      uint2 u; u.x = pk2(v[0], v[1]); u.y = pk2(v[2], v[3]);
      *(uint2*)(SQ + tI * 144 + (32 * st_ + 8 * a4 + 4 * h) * 2) = u;
    }
    dsum += __shfl_xor(dsum, 32);
    if (h == 0) denp[w * 32 + r] = dsum;
  } else {
    const int row = lane >> 1, hf = lane & 1;
    *(u32x4*)(SQ + row * 144 + 64 + hf * 32) = (u32x4){0u, 0u, 0u, 0u};
    *(u32x4*)(SQ + row * 144 + 64 + hf * 32 + 16) = (u32x4){0u, 0u, 0u, 0u};
  }
  __syncthreads();
  {
    bf16x8 vf[4];
#pragma unroll
    for (int kk = 0; kk < 4; ++kk) vf[kk] = tr_pair(Vl + (16 * kk + 8 * h + tq) * STR + (32 * w + 16 * blk + 4 * tp) * 2, 4 * STR);
#pragma unroll
    for (int tt = 0; tt < 2; ++tt) {
      f32x16 num = zero16();
#pragma unroll
      for (int kk = 0; kk < 2 + 2 * tt; ++kk) {
        bf16x8 bq = *(const bf16x8*)(SQ + (32 * tt + r) * 144 + (16 * kk + 8 * h) * 2);
        num = MFMA(vf[kk], bq, num);
      }
      u16* yo = (u16*)p.out + (tokb + 32 * tt + r) * 2048 + 1024 + hh * 128 + 32 * w + 4 * h;
#pragma unroll
      for (int a4 = 0; a4 < 4; ++a4) {
        uint2 u; u.x = pk2(num[4 * a4], num[4 * a4 + 1]); u.y = pk2(num[4 * a4 + 2], num[4 * a4 + 3]);
        *(uint2*)(yo + 8 * a4) = u;
      }
    }
    if (tid < 64) sc[128 + tid] = (tid < 32) ? denp[tid] : (denp[32 + (tid - 32)] + denp[64 + (tid - 32)]);
    {
      const int dcg = (tid & 15) * 8, tkg = (tid >> 4) * 4;
      const float4 g0 = *(const float4*)(p.head_g + hh * 128 + dcg), g1 = *(const float4*)(p.head_g + hh * 128 + dcg + 4);
#pragma unroll
      for (int o = 0; o < 4; ++o) {
        u16* op = p.z + (tokb + tkg + o) * ZW + 4096 + hh * 128 + dcg;
        const u32x4 ov = *(const u32x4*)op;
        u32x4 gv;
        gv.x = pk2(sigmoidf_(bflo(ov.x)) * g0.x, sigmoidf_(bfhi(ov.x)) * g0.y); gv.y = pk2(sigmoidf_(bflo(ov.y)) * g0.z, sigmoidf_(bfhi(ov.y)) * g0.w);
        gv.z = pk2(sigmoidf_(bflo(ov.z)) * g1.x, sigmoidf_(bfhi(ov.z)) * g1.y); gv.w = pk2(sigmoidf_(bflo(ov.w)) * g1.z, sigmoidf_(bfhi(ov.w)) * g1.w);
        *(u32x4*)op = gv;
      }
    }
    const int dc = (tid & 15) * 8, tk0 = (tid >> 4) * 4;
    u16* zq = p.z + (tokb + tk0) * ZW + 2560 + hh * 128 + dc;
#pragma unroll
    for (int o = 0; o < 4; ++o) {
      *(u32x4*)(zq + (long)o * ZW) = *(const u32x4*)(Ql + (tk0 + o) * STR + dc * 2);
      *(u32x4*)(zq + 512 + (long)o * ZW) = *(const u32x4*)(Kl + (tk0 + o) * STR + dc * 2);
    }
  }
  __syncthreads();
}

DI void mlchain_item(const Params& p, int b, int hh, char* lds, int tid) {
  const int lane = tid & 63, w = tid >> 6, r = lane & 31, h = lane >> 5;
  const int i16 = lane & 15, tq = i16 >> 2, tp = i16 & 3, blk = (lane >> 4) & 1;
  constexpr int STR = 272;
  char* Ql = lds; char* Kl = lds + 17408; char* Vl = lds + 34816;
  float* scl = (float*)(lds + 52224);
  float* ssq = scl + 320;
  float* nvec = ssq + 256;
  float* nqv = nvec + 256;
  float* npart = nqv + 64;
  f32x16 CT[4];
#pragma unroll
  for (int d = 0; d < 4; ++d) CT[d] = zero16();
  float nreg = 0.f;
  nvec[tid] = 0.f;
  if (tid < 64) nqv[tid] = 0.f;
  const int dc = (tid & 15) * 8, tk0 = (tid >> 4) * 4;
  const u16* zrow = p.z + ((long)b * 2048 + tk0) * ZW + 2560 + hh * 128 + dc;
  const float* scg = p.mlsc + (long)((b * 4 + hh) * 32) * 320;
  {
#pragma unroll
    for (int o = 0; o < 4; ++o) {
      const u32x4 vq = *(const u32x4*)(zrow + (long)o * ZW), vk = *(const u32x4*)(zrow + 512 + (long)o * ZW), vv = *(const u32x4*)(zrow + 1024 + (long)o * ZW);
      *(u32x4*)(Ql + (tk0 + o) * STR + dc * 2) = vq;
      *(u32x4*)(Kl + (tk0 + o) * STR + dc * 2) = vk;
      *(u32x4*)(Vl + (tk0 + o) * STR + dc * 2) = vv;
    }
    scl[tid] = scg[tid];
    if (tid < 64) scl[256 + tid] = scg[256 + tid];
  }
  __syncthreads();
  for (int c_ = 0; c_ < 32; ++c_) {
    int c = c_;
    asm volatile("" : "+s"(c));
    const long tokb = (long)b * 2048 + c * 64;
    const int cn = (c < 31) ? c + 1 : 31;
    const u16* zrn = zrow + (long)cn * 64 * ZW;
    u32x4 pq[4];
#pragma unroll
    for (int o = 0; o < 4; ++o) pq[o] = *(const u32x4*)(zrn + (long)o * ZW);
    const float psc0 = scg[cn * 320 + tid];
    const float psc1 = scg[cn * 320 + 256 + (tid & 63)];
    const float* nv = nvec + (c & 1) * 128;
    const float decay = scl[256];
    unsigned hvp[2][8];
    uint2 nia[2][4];
#pragma unroll
    for (int tt = 0; tt < 2; ++tt) {
      const u16* yi = (const u16*)p.out + (tokb + 32 * tt + r) * 2048 + 1024 + hh * 128 + 32 * w + 4 * h;
#pragma unroll
      for (int a4 = 0; a4 < 4; ++a4) nia[tt][a4] = *(const uint2*)(yi + 8 * a4);
    }
    f32x16 numv[2];
    numv[0] = zero16(); numv[1] = zero16();
#pragma unroll
    for (int dt = 0; dt < 4; ++dt) {
      bf16x8 bqv[2][2];
#pragma unroll
      for (int s2 = 0; s2 < 2; ++s2)
#pragma unroll
        for (int tt = 0; tt < 2; ++tt) {
          const char* qrow = Ql + (32 * tt + r) * STR + (32 * dt + 16 * s2 + 4 * h) * 2;
          bqv[s2][tt] = cat8(*(const s16x4*)qrow, *(const s16x4*)(qrow + 16));
        }
#pragma unroll
      for (int s2 = 0; s2 < 2; ++s2) {
        const bf16x8 a = pack8(CT[dt], s2);
        numv[0] = MFMA(a, bqv[s2][0], numv[0]);
        numv[1] = MFMA(a, bqv[s2][1], numv[1]);
      }
    }
#pragma unroll
    for (int tt = 0; tt < 2; ++tt) {
      const int tI = 32 * tt + r;
      const uint2 (&ni)[4] = nia[tt];
      const f32x16& num = numv[tt];
      const float an = nqv[tI];
      const float iw = scl[tI];
      const float den = scl[128 + tI] + iw * an;
      const float dn = fmaxf(fabsf(den), scl[64 + tI]);
      const float inv = 1.0f / dn;
      float ss = 0.f;
#pragma unroll
      for (int a4 = 0; a4 < 4; ++a4) {
        const float v0 = (bflo(ni[a4].x) + iw * num[4 * a4]) * inv, v1 = (bfhi(ni[a4].x) + iw * num[4 * a4 + 1]) * inv;
        const float v2 = (bflo(ni[a4].y) + iw * num[4 * a4 + 2]) * inv, v3 = (bfhi(ni[a4].y) + iw * num[4 * a4 + 3]) * inv;
        hvp[tt][2 * a4] = pk2(v0, v1); hvp[tt][2 * a4 + 1] = pk2(v2, v3);
        ss += v0 * v0 + v1 * v1 + v2 * v2 + v3 * v3;
      }
      ss += __shfl_xor(ss, 32);
      if (h == 0) ssq[w * 64 + tI] = ss;
    }
    {
      float p0 = 0.f, p1 = 0.f;
#pragma unroll
      for (int s4 = 0; s4 < 4; ++s4) {
        const float4 ws4 = *(const float4*)(scl + 192 + 16 * w + 4 * s4);
        const unsigned ka = *(const unsigned*)(Kl + (16 * w + 4 * s4) * STR + lane * 4), kb2 = *(const unsigned*)(Kl + (16 * w + 4 * s4 + 1) * STR + lane * 4);
        const unsigned kc2 = *(const unsigned*)(Kl + (16 * w + 4 * s4 + 2) * STR + lane * 4), kd = *(const unsigned*)(Kl + (16 * w + 4 * s4 + 3) * STR + lane * 4);
        p0 += ws4.x * bflo(ka) + ws4.y * bflo(kb2) + ws4.z * bflo(kc2) + ws4.w * bflo(kd);
        p1 += ws4.x * bfhi(ka) + ws4.y * bfhi(kb2) + ws4.z * bfhi(kc2) + ws4.w * bfhi(kd);
      }
      *(float2*)(npart + w * 128 + 2 * lane) = make_float2(p0, p1);
    }
    __syncthreads();
#pragma unroll
    for (int o = 0; o < 4; ++o) *(u32x4*)(Ql + (tk0 + o) * STR + dc * 2) = pq[o];
    u32x4 pk[4], pv[4];
#pragma unroll
    for (int o = 0; o < 4; ++o) { pk[o] = *(const u32x4*)(zrn + 512 + (long)o * ZW); pv[o] = *(const u32x4*)(zrn + 1024 + (long)o * ZW); }
    uint2 ogv[2][4];
#pragma unroll
    for (int tt = 0; tt < 2; ++tt)
#pragma unroll
      for (int a4 = 0; a4 < 4; ++a4) ogv[tt][a4] = *(const uint2*)(p.z + (tokb + 32 * tt + r) * ZW + 4096 + hh * 128 + 32 * w + 8 * a4 + 4 * h);
    {
#pragma unroll
      for (int dt = 0; dt < 4; ++dt)
#pragma unroll
        for (int i = 0; i < 16; ++i) CT[dt][i] *= decay;
#pragma unroll
      for (int kk = 0; kk < 4; ++kk) {
        const bf16x8 vfr = tr_pair(Vl + (16 * kk + 8 * h + tq) * STR + (32 * w + 16 * blk + 4 * tp) * 2, 4 * STR);
        const float4 w0 = *(const float4*)(scl + 192 + 16 * kk + 8 * h), w1 = *(const float4*)(scl + 192 + 16 * kk + 8 * h + 4);
        const u32x4 u = __builtin_bit_cast(u32x4, vfr);
        u32x4 o;
        o.x = pk2(bflo(u.x) * w0.x, bfhi(u.x) * w0.y); o.y = pk2(bflo(u.y) * w0.z, bfhi(u.y) * w0.w);
        o.z = pk2(bflo(u.z) * w1.x, bfhi(u.z) * w1.y); o.w = pk2(bflo(u.w) * w1.z, bfhi(u.w) * w1.w);
        const bf16x8 bw = __builtin_bit_cast(bf16x8, o);
        bf16x8 kf[4];
#pragma unroll
        for (int dt = 0; dt < 4; ++dt) kf[dt] = tr_pair(Kl + (16 * kk + 8 * h + tq) * STR + (32 * dt + 16 * blk + 4 * tp) * 2, 4 * STR);
#pragma unroll
        for (int dt = 0; dt < 4; ++dt) CT[dt] = MFMA(kf[dt], bw, CT[dt]);
      }
    }
    if (tid < 128) {
      const float nn = decay * nreg + ((npart[tid] + npart[128 + tid]) + (npart[256 + tid] + npart[384 + tid]));
      nreg = nn; nvec[((c + 1) & 1) * 128 + tid] = nn;
    }
    __syncthreads();
#pragma unroll
    for (int o = 0; o < 4; ++o) {
      *(u32x4*)(Kl + (tk0 + o) * STR + dc * 2) = pk[o];
      *(u32x4*)(Vl + (tk0 + o) * STR + dc * 2) = pv[o];
    }
    scl[tid] = psc0;
    if (tid < 64) scl[256 + tid] = psc1;
    {
      const int tn = 16 * w + (lane & 15), dq = lane >> 4;
      const float* nvn = nvec + ((c + 1) & 1) * 128 + 32 * dq;
      float an = 0.f;
#pragma unroll
      for (int d8 = 0; d8 < 4; ++d8) {
        const u32x4 qv = *(const u32x4*)(Ql + tn * STR + (32 * dq + 8 * d8) * 2);
        const float4 n0 = *(const float4*)(nvn + 8 * d8), n1 = *(const float4*)(nvn + 8 * d8 + 4);
        an += n0.x * bflo(qv.x) + n0.y * bfhi(qv.x) + n0.z * bflo(qv.y) + n0.w * bfhi(qv.y) + n1.x * bflo(qv.z) + n1.y * bfhi(qv.z) + n1.z * bflo(qv.w) + n1.w * bfhi(qv.w);
      }
      an += __shfl_xor(an, 16);
      an += __shfl_xor(an, 32);
      if (lane < 16) nqv[tn] = an;
    }
#pragma unroll
    for (int tt = 0; tt < 2; ++tt) {
      const int tI = 32 * tt + r;
      const float ss = ssq[tI] + ssq[64 + tI] + ssq[128 + tI] + ssq[192 + tI];
      const float rn = rsqrtf(ss * (1.0f / 128.0f) + 1e-6f);
      const long tokg = tokb + tI;
#pragma unroll
      for (int a4 = 0; a4 < 4; ++a4) {
        const int e0 = 32 * w + 8 * a4 + 4 * h;
        const uint2 og = ogv[tt][a4];
        uint2 u;
        u.x = pk2(bflo(hvp[tt][2 * a4]) * rn * bflo(og.x), bfhi(hvp[tt][2 * a4]) * rn * bfhi(og.x));
        u.y = pk2(bflo(hvp[tt][2 * a4 + 1]) * rn * bflo(og.y), bfhi(hvp[tt][2 * a4 + 1]) * rn * bfhi(og.y));
        *(uint2*)((u16*)p.out + tokg * 2048 + 1024 + hh * 128 + e0) = u;
      }
    }
    __syncthreads();
  }
  __syncthreads();
}

DI void phase_two(const Params& p, char* lds, int tid) {
  if (blockIdx.x == 0 && tid == 0) { int* c_ = p.ctr; asm volatile("" : "+s"(c_)); __hip_atomic_store(c_ + 1, 0, __ATOMIC_RELAXED, __HIP_MEMORY_SCOPE_AGENT); }
  int* sh_item = (int*)(lds + LDS_BYTES + 32);
  while (true) {
    if (tid == 0) *sh_item = atomicAdd(p.ctr, 1);
    __syncthreads();
    const int it = *sh_item;
    __syncthreads();
    if (it >= 128 + 1024) break;
    int tid2 = tid;
    asm volatile("" : "+v"(tid2));
    if (it < 128) compress_item(p, it, lds, tid2);
    else { const int q = it - 128; mlpre_item(p, (q & 31) >> 2, q & 3, q >> 5, lds, tid2); }
    __syncthreads();
  }
}

DI void phase_mixers(const Params& p, char* lds, int tid, int it_base, int it_end, bool do_chain) {
  if (blockIdx.x == 0 && tid == 0) { int* c_ = p.ctr; asm volatile("" : "+s"(c_)); __hip_atomic_store(c_ + 0, 0, __ATOMIC_RELAXED, __HIP_MEMORY_SCOPE_AGENT); }
  int* sh_item = (int*)(lds + LDS_BYTES + 32);
  const int half = gridDim.x >> 1;
  if (do_chain && blockIdx.x < 32) {
    int tid2 = tid;
    asm volatile("" : "+v"(tid2));
    if (ITEM_MASK & 1) mlchain_item(p, blockIdx.x >> 2, blockIdx.x & 3, lds, tid2);
    __syncthreads();
    if (tid == 0) __hip_atomic_store(p.ctr + 32 + blockIdx.x, 1, __ATOMIC_RELAXED, __HIP_MEMORY_SCOPE_AGENT);
  } else if (do_chain && half >= 32 && (int)blockIdx.x >= half && (int)blockIdx.x < half + 32) {
    if (tid == 0) {
      unsigned spins = 0;
      while (__hip_atomic_load(p.ctr + 32 + (blockIdx.x - half), __ATOMIC_RELAXED, __HIP_MEMORY_SCOPE_AGENT) == 0 && ++spins < (1u << 22)) __builtin_amdgcn_s_sleep(32);
    }
    __syncthreads();
  }
  while (true) {
    if (tid == 0) *sh_item = atomicAdd(p.ctr + 1, 1) + it_base;
    __syncthreads();
    const int it = *sh_item;
    __syncthreads();
    if (it >= it_end) break;
    int tid2 = tid;
    asm volatile("" : "+v"(tid2));
    if (it < 2048) { const int j = it; if (ITEM_MASK & 2) nsa_item(p, (j & 31) >> 2, j & 3, 63 - (j >> 5), lds, tid2); }
    else { const int j = it - 2048; if (ITEM_MASK & 4) mem_item(p, j >> 6, (j >> 4) & 3, j & 15, lds, tid2); }
    __syncthreads();
  }
}

DI void phase_merge(const Params& p, char* lds, int tid) {
  const int lane = tid & 63, w = tid >> 6, wm = w >> 1, wn = w & 1, r = lane & 31, h = lane >> 5;
  const u16* ycat = (const u16*)p.out;
  for (int it = 0;; ++it) {
    int mt, nt;
    if (!tile_xcd(it, 128, 8, mt, nt)) break;
    const long m0 = (long)mt * 128; const int n0 = nt * 128;
    unsigned ypk[2][2][8];
#pragma unroll
    for (int a = 0; a < 2; ++a)
#pragma unroll
      for (int c = 0; c < 2; ++c)
#pragma unroll
        for (int i = 0; i < 8; ++i) ypk[a][c][i] = 0u;
#pragma unroll 1
    for (int br = 0; br < 3; ++br) {
      f32x16 acc[2][2];
      for (int a = 0; a < 2; ++a) for (int c = 0; c < 2; ++c) acc[a][c] = zero16();
      gemm_kloop<false>(acc, APlain{p.hbuf + m0 * 1024, 1024}, p.WinT + (long)(5248 + br * 1024 + n0) * 1024, 1024, 1024, lds, tid);
      unsigned gpk[2][2][8];
#pragma unroll
      for (int a = 0; a < 2; ++a)
#pragma unroll
        for (int c = 0; c < 2; ++c)
#pragma unroll
          for (int i = 0; i < 8; ++i) gpk[a][c][i] = pk2(sigmoidf_(acc[a][c][2 * i]), sigmoidf_(acc[a][c][2 * i + 1]));
      for (int a = 0; a < 2; ++a) for (int c = 0; c < 2; ++c) acc[a][c] = zero16();
      const int Kb = (br == 0) ? 1024 : 512;
      const int off = (br == 0) ? 0 : (br == 1 ? 1024 : 1536);
      const u16* WT = (br == 0) ? p.WpnT : (br == 1 ? p.WpmlT : p.WpmemT);
      gemm_kloop<true>(acc, APlain{ycat + m0 * 2048 + off, 2048}, WT + (long)n0 * Kb, Kb, Kb, lds, tid);
#pragma unroll
      for (int a = 0; a < 2; ++a)
#pragma unroll
        for (int c = 0; c < 2; ++c)
#pragma unroll
          for (int i = 0; i < 8; ++i)
            ypk[a][c][i] = pk2(bflo(ypk[a][c][i]) + bflo(gpk[a][c][i]) * acc[a][c][2 * i], bfhi(ypk[a][c][i]) + bfhi(gpk[a][c][i]) * acc[a][c][2 * i + 1]);
    }
    {
      f32x16 yv[2][2];
#pragma unroll
      for (int a = 0; a < 2; ++a)
#pragma unroll
        for (int c = 0; c < 2; ++c)
#pragma unroll
          for (int i = 0; i < 8; ++i) { yv[a][c][2 * i] = bflo(ypk[a][c][i]); yv[a][c][2 * i + 1] = bfhi(ypk[a][c][i]); }
      store_tile_bf16(yv, p.ybuf + m0 * 1024 + n0, 1024, lds, tid);
    }
  }
}

DI void phase_gemm_ss(const u16* A, int lda, const u16* Bt, int K, u16* tout, float* ssp, char* lds, int tid) {
  for (int it = 0;; ++it) {
    int mt, nt;
    if (!tile_xcd(it, 64, 8, mt, nt)) break;
    const long m0 = (long)mt * 256; const int n0 = nt * 128;
    f32x16 acc[4][2];
    for (int a = 0; a < 4; ++a) for (int c = 0; c < 2; ++c) acc[a][c] = zero16();
    gemm_kloop256(acc, APlain{A + m0 * lda, lda}, Bt + (long)n0 * K, K, K, lds, tid);
    {
      int t3 = tid;
      asm volatile("" : "+v"(t3));
      const int wm = (t3 >> 7) & 1, wn = (t3 >> 6) & 1, r = t3 & 31, h = (t3 >> 5) & 1;
#pragma unroll
      for (int mi = 0; mi < 4; ++mi) {
        float ss = 0.f;
#pragma unroll
        for (int ni = 0; ni < 2; ++ni)
#pragma unroll
          for (int i = 0; i < 16; ++i) ss += acc[mi][ni][i] * acc[mi][ni][i];
        ss += __shfl_xor(ss, 32);
        if (h == 0) ssp[(m0 + EPI_M4(mi)) * 16 + nt * 2 + wn] = ss;
      }
    }
    store_tile256_bf16(acc, tout + m0 * 1024 + n0, 1024, lds, tid);
  }
}

DI void phase_rows1(const Params& p, int tid) {
  const int lane = tid & 63, w = tid >> 6;
  const int stride = gridDim.x * 4;
  for (int row0 = blockIdx.x * 4 + w; row0 < T_TOK; row0 += 4 * stride) {
    float ssv[4]; float4 xv[4][4]; uint2 tb[4][4];
#pragma unroll
    for (int k = 0; k < 4; ++k) {
      const int row = (row0 + k * stride < T_TOK) ? row0 + k * stride : row0;
      ssv[k] = (lane < 16) ? p.ssp[(long)row * 16 + lane] : 0.f;
#pragma unroll
      for (int i = 0; i < 4; ++i) {
        xv[k][i] = ldnt4(p.x + (long)row * 1024 + 4 * (lane + 64 * i));
        tb[k][i] = ldnt2u(p.t1 + (long)row * 1024 + 4 * (lane + 64 * i));
      }
    }
#pragma unroll
    for (int k = 0; k < 4; ++k) {
      const int row = row0 + k * stride;
      if (row < T_TOK) {
        const float rn = rsqrtf(wave_sum(ssv[k]) * (1.0f / 1024.0f) + 1e-6f);
        float4 v[4]; float s2 = 0.f;
#pragma unroll
        for (int i = 0; i < 4; ++i) {
          const float4 tv = make_float4(bflo(tb[k][i].x), bfhi(tb[k][i].x), bflo(tb[k][i].y), bfhi(tb[k][i].y));
          const float4 gg = ((const float4*)p.g_post_mix)[lane + 64 * i];
          v[i].x = xv[k][i].x + tv.x * rn * gg.x; v[i].y = xv[k][i].y + tv.y * rn * gg.y; v[i].z = xv[k][i].z + tv.z * rn * gg.z; v[i].w = xv[k][i].w + tv.w * rn * gg.w;
          s2 += v[i].x * v[i].x + v[i].y * v[i].y + v[i].z * v[i].z + v[i].w * v[i].w;
        }
        const float rn2 = rsqrtf(wave_sum(s2) * (1.0f / 1024.0f) + 1e-6f);
#pragma unroll
        for (int i = 0; i < 4; ++i) {
          const float4 gg = ((const float4*)p.g_pre_ffn)[lane + 64 * i];
          uint2 o; o.x = pk2(v[i].x * rn2 * gg.x, v[i].y * rn2 * gg.y); o.y = pk2(v[i].z * rn2 * gg.z, v[i].w * rn2 * gg.w);
          ((uint2*)(p.hbuf + (long)row * 1024))[lane + 64 * i] = o;
        }
      }
    }
  }
}

DI void phase_ffn_in(const Params& p, char* lds, int tid) {
  for (int it = 0;; ++it) {
    int mt, nt;
    if (!tile_xcd(it, 64, 44, mt, nt)) break;
    const long m0 = (long)mt * 256;
    f32x16 acc[4][2];
    for (int a = 0; a < 4; ++a) for (int c = 0; c < 2; ++c) acc[a][c] = zero16();
    gemm_kloop256(acc, APlain{p.hbuf + m0 * 1024, 1024}, p.WffT + (long)nt * 128 * 1024, 1024, 1024, lds, tid);
    int t3 = tid;
    asm volatile("" : "+v"(t3));
    const int wm = (t3 >> 7) & 1, wn = (t3 >> 6) & 1, r = t3 & 31, h = (t3 >> 5) & 1;
#pragma unroll
    for (int mi = 0; mi < 4; ++mi)
#pragma unroll
      for (int a4 = 0; a4 < 4; ++a4) {
        uint2 u;
        u.x = pk2(siluf_(acc[mi][0][4 * a4]) * acc[mi][1][4 * a4], siluf_(acc[mi][0][4 * a4 + 1]) * acc[mi][1][4 * a4 + 1]);
        u.y = pk2(siluf_(acc[mi][0][4 * a4 + 2]) * acc[mi][1][4 * a4 + 2], siluf_(acc[mi][0][4 * a4 + 3]) * acc[mi][1][4 * a4 + 3]);
        *(uint2*)(lds + EPI_M4(mi) * 144 + (wn * 32 + 8 * a4 + 4 * h) * 2) = u;
      }
    __syncthreads();
#pragma unroll
    for (int i = 0; i < 8; ++i) {
      const int c = t3 + 256 * i, row = c >> 3, cc = c & 7;
      *(u32x4*)(p.act + (m0 + row) * 2816 + nt * 64 + cc * 8) = *(const u32x4*)(lds + row * 144 + cc * 16);
    }
    __syncthreads();
  }
}

DI void phase_rows2(const Params& p, int tid) {
  const int lane = tid & 63, w = tid >> 6;
  const int stride = gridDim.x * 4;
  for (int row0 = blockIdx.x * 4 + w; row0 < T_TOK; row0 += 4 * stride) {
    float s1v[4], s2v[4]; float4 xv[4][4]; uint2 ta[4][4], tb[4][4];
#pragma unroll
    for (int k = 0; k < 4; ++k) {
      const int row = (row0 + k * stride < T_TOK) ? row0 + k * stride : row0;
      s1v[k] = (lane < 16) ? p.ssp[(long)row * 16 + lane] : 0.f;
      s2v[k] = (lane < 16) ? p.ssp2[(long)row * 16 + lane] : 0.f;
#pragma unroll
      for (int i = 0; i < 4; ++i) {
        xv[k][i] = ldnt4(p.x + (long)row * 1024 + 4 * (lane + 64 * i));
        ta[k][i] = ldnt2u(p.t1 + (long)row * 1024 + 4 * (lane + 64 * i));
        tb[k][i] = ldnt2u(p.t2 + (long)row * 1024 + 4 * (lane + 64 * i));
      }
    }
#pragma unroll
    for (int k = 0; k < 4; ++k) {
      const int row = row0 + k * stride;
      if (row < T_TOK) {
        const float rn1 = rsqrtf(wave_sum(s1v[k]) * (1.0f / 1024.0f) + 1e-6f);
        const float rn2 = rsqrtf(wave_sum(s2v[k]) * (1.0f / 1024.0f) + 1e-6f);
#pragma unroll
        for (int i = 0; i < 4; ++i) {
          const float4 t1v = make_float4(bflo(ta[k][i].x), bfhi(ta[k][i].x), bflo(ta[k][i].y), bfhi(ta[k][i].y));
          const float4 t2v = make_float4(bflo(tb[k][i].x), bfhi(tb[k][i].x), bflo(tb[k][i].y), bfhi(tb[k][i].y));
          const float4 g1 = ((const float4*)p.g_post_mix)[lane + 64 * i];
          const float4 g2 = ((const float4*)p.g_post_ffn)[lane + 64 * i];
          float4 o;
          o.x = xv[k][i].x + t1v.x * rn1 * g1.x; o.y = xv[k][i].y + t1v.y * rn1 * g1.y; o.z = xv[k][i].z + t1v.z * rn1 * g1.z; o.w = xv[k][i].w + t1v.w * rn1 * g1.w;
          o.x += t2v.x * rn2 * g2.x; o.y += t2v.y * rn2 * g2.y; o.z += t2v.z * rn2 * g2.z; o.w += t2v.w * rn2 * g2.w;
          stnt4(p.out + (long)row * 1024 + 4 * (lane + 64 * i), o);
        }
      }
    }
  }
}

__global__ void __launch_bounds__(256, 2) hybrid_fwd(Params p, int ph_lo, int ph_hi, unsigned long long prog) {
  extern __shared__ __attribute__((aligned(16))) char lds[];
  const int wave_id = __builtin_amdgcn_readfirstlane((int)(threadIdx.x >> 6));
  if (threadIdx.x == 0) *(uint4*)(lds + LDS_BYTES) = make_uint4(0u, 0u, 0u, 0u);
  __syncthreads();
  XcdBarrier xb = xcd_barrier_post(p.bar, (volatile LAS unsigned*)(lds + LDS_BYTES));
  for (int pi = ph_lo; pi < ph_hi; ++pi) {
    const int ph = (int)((prog >> (4 * pi)) & 15ull);
    unsigned zero_ = 0u;
    asm volatile("" : "+s"(zero_));
    int tid = wave_id * 64 + (int)__builtin_amdgcn_mbcnt_hi(~0u, __builtin_amdgcn_mbcnt_lo(~0u, zero_));
    asm volatile("" : "+v"(tid));
    switch (ph) {
#define ON(n) (ONLY < 0 || ONLY == n)
      case 0: if (ON(0)) phase_prep(p, lds, tid); break;
      case 1: if (ON(1)) phase_gemm_in(p, lds, tid); break;
      case 14: phase_ml_summaries(p, tid); break;
      case 15: if (blockIdx.x == 0 && tid == 0) { int* c_ = p.ctr; asm volatile("" : "+s"(c_)); __hip_atomic_store(c_ + 0, 0, __ATOMIC_RELAXED, __HIP_MEMORY_SCOPE_AGENT); } break;
      case 2: if (ON(2)) phase_two(p, lds, tid); break;
      case 13: if (blockIdx.x == 0 && tid == 0) { int* c_ = p.ctr; asm volatile("" : "+s"(c_)); __hip_atomic_store(c_ + 1, 0, __ATOMIC_RELAXED, __HIP_MEMORY_SCOPE_AGENT); } break;
      case 3: case 10: case 11: case 12: if (ON(3)) phase_mixers(p, lds, tid, ph == 12 ? 2048 : 0, ph == 11 ? 2048 : 2560, ph == 3); break;
      case 4: if (ON(4)) phase_merge(p, lds, tid); break;
      case 5: if (ON(5)) phase_gemm_ss(p.ybuf, 1024, p.WoutT, 1024, p.t1, p.ssp, lds, tid); break;
      case 6: if (ON(6)) phase_rows1(p, tid); break;
      case 7: if (ON(7)) phase_ffn_in(p, lds, tid); break;
      case 8: if (ON(8)) phase_gemm_ss(p.act, 2816, p.WdnT, 2816, p.t2, p.ssp2, lds, tid); break;
      default: if (ON(9)) phase_rows2(p, tid); break;
    }
    if (pi + 1 < ph_hi) {
      if (ph_hi > 1000) cg::this_grid().sync();
      xcd_barrier(xb, tid);
    }
  }
}

extern "C" void kernel_launch(void* const* d_in, const int* in_sizes, int n_in, void* d_out, int out_size, void* d_ws, size_t ws_size,
                              hipStream_t stream) {
  static int grid = 0;
  if (grid == 0) {
    int dev = 0, cus = 0, per_cu = 0;
    hipGetDevice(&dev);
    hipDeviceGetAttribute(&cus, hipDeviceAttributeMultiprocessorCount, dev);
    hipFuncSetAttribute((const void*)hybrid_fwd, hipFuncAttributeMaxDynamicSharedMemorySize, LDS_TOTAL);
    hipOccupancyMaxActiveBlocksPerMultiprocessor(&per_cu, (const void*)hybrid_fwd, 256, LDS_TOTAL);
    if (per_cu < 1) per_cu = 1;
    if (per_cu > 2) per_cu = 2;
    grid = cus * per_cu;
    grid -= grid % 8;
    if (grid < 8) grid = 8;
  }
  Params p{};
  const float** ins = (const float**)&p;
  for (int i = 0; i < 25; ++i) ins[i] = (const float*)d_in[i];
  p.out = (float*)d_out;
  char* ws = (char*)d_ws;
  size_t off = 0;
  auto take = [&](size_t bytes) { char* q = ws + off; off += (bytes + 255) & ~(size_t)255; return q; };
  char* zreg = take((size_t)T_TOK * ZW * 2);
  p.z = (u16*)zreg;
  p.ybuf = (u16*)zreg;
  p.t1 = (u16*)(zreg + ((size_t)128 << 20));
  p.act = (u16*)zreg;
  p.t2 = (u16*)(zreg + ((size_t)96 << 20));
  p.hbuf = (u16*)take((size_t)T_TOK * 1024 * 2);
  p.WinT = (u16*)take((size_t)8320 * 1024 * 2);
  p.WffT = (u16*)take((size_t)5632 * 1024 * 2);
  p.WdnT = (u16*)take((size_t)1024 * 2816 * 2);
  p.WmkvT = (u16*)take((size_t)1024 * 1024 * 2);
  p.WpnT = (u16*)take((size_t)1024 * 1024 * 2);
  p.WpmlT = (u16*)take((size_t)1024 * 512 * 2);
  p.WpmemT = (u16*)take((size_t)1024 * 512 * 2);
  p.WoutT = (u16*)take((size_t)1024 * 1024 * 2);
  p.W1kT = (u16*)take((size_t)128 * 2048 * 2);
  p.W1vT = (u16*)take((size_t)128 * 2048 * 2);
  p.memn = (u16*)take((size_t)2048 * 1024 * 2);
  p.kvm = (u16*)take((size_t)2048 * 1024 * 2);
  p.kc = (u16*)take((size_t)32 * 128 * 64 * 2);
  p.vc = (u16*)take((size_t)32 * 128 * 64 * 2);
  p.zf = (float*)take((size_t)T_TOK * 64 * 4);
  p.ssp = (float*)take((size_t)T_TOK * 16 * 4);
  p.ssp2 = (float*)take((size_t)T_TOK * 16 * 4);
  p.cbias = (float*)take((256 + 32 * 128) * 4);
  p.ctr = (int*)take(256);
  p.mlsc = (float*)take((size_t)1024 * 320 * 4);
  p.mlba = (float*)take((size_t)1024 * 2 * 4);
  p.halo = (u16*)take((size_t)256 * 3 * 1024 * 2);
  p.bar = (unsigned*)take((size_t)XCD_BAR_WORDS * 4);
  if (off > ws_size) { fprintf(stderr, "kernel_launch: workspace too small (%zu needed, %zu given)\n", off, ws_size); return; }
  hipMemsetAsync(p.bar, 0, (size_t)XCD_BAR_WORDS * 4, stream);
#ifndef PROG
 #define PROG {0, 1, 2, 3, 4, 5, 6, 7, 8, 9}
#endif
  const int progl[] = PROG;
  unsigned long long prog = 0ull; int nprog = 0;
  for (int ph : progl) prog |= (unsigned long long)ph << (4 * nprog++);
#if COOP
  int lo = 0, hi = nprog;
  void* args[] = {&p, &lo, &hi, &prog};
  hipError_t e = hipLaunchCooperativeKernel((const void*)hybrid_fwd, dim3(grid), dim3(256), args, LDS_TOTAL, stream);
  if (e != hipSuccess) fprintf(stderr, "cooperative launch failed: %s (grid %d)\n", hipGetErrorString(e), grid);
#else
  for (int ph = 0; ph < nprog; ++ph) hipLaunchKernelGGL(hybrid_fwd, dim3(grid), dim3(256), LDS_TOTAL, stream, p, ph, ph + 1, prog);
#endif
}
```

```cpp
#include <hip/hip_runtime.h>
#include <hip/hip_cooperative_groups.h>
#include <cstdio>
namespace cg = cooperative_groups;

#ifndef COOP
#define COOP 1
#endif
#ifndef ITEM_MASK
#define ITEM_MASK 7
#endif
#ifndef ONLY
#define ONLY -1
#endif

typedef unsigned short u16;
using bf16x8 = __attribute__((ext_vector_type(8))) short;
using s16x4  = __attribute__((ext_vector_type(4))) short;
using f32x16 = __attribute__((ext_vector_type(16))) float;
typedef __attribute__((ext_vector_type(2))) __bf16 bf2_t;
typedef __attribute__((ext_vector_type(2))) float f2_t;
typedef __attribute__((ext_vector_type(4))) unsigned u32x4;

#define DI __device__ __forceinline__
#define MFMA(a, b, c) __builtin_amdgcn_mfma_f32_32x32x16_bf16((a), (b), (c), 0, 0, 0)

constexpr int T_TOK = 16384;
constexpr int ZW = 5120;
constexpr int LDS_BYTES = 73728;
constexpr int LDS_TOTAL = LDS_BYTES + 64;

struct Params {
  const float *x, *mem, *g_pre_mix, *w_in, *pe_k, *w1_k, *w2_k, *pe_v, *w1_v, *w2_v, *conv_w, *conv_b, *gate_b,
      *head_g, *g_mem, *w_mem_kv, *w_pn, *w_pml, *w_pmem, *w_out, *g_post_mix, *g_pre_ffn, *w_ffin, *w_ffdn, *g_post_ffn;
  float* out;
  u16 *z, *hbuf, *WinT, *WffT, *WdnT, *WmkvT, *WpnT, *WpmlT, *WpmemT, *WoutT, *W1kT, *W1vT, *memn, *kvm, *kc, *vc;
  float *zf, *ssp, *cbias, *mlsc, *mlba;
  u16* halo;
  int* ctr;
  unsigned* bar;
  u16 *ybuf, *act;
  u16 *t1, *t2;
};

DI unsigned pk2(float a, float b) { f2_t v; v[0] = a; v[1] = b; bf2_t p = __builtin_convertvector(v, bf2_t); return __builtin_bit_cast(unsigned, p); }
DI u16 f2bf(float a) { return (u16)(pk2(a, 0.f) & 0xffffu); }
DI float bf2f(u16 v) { return __uint_as_float(((unsigned)v) << 16); }
DI float bflo(unsigned u) { return __uint_as_float(u << 16); }
DI float bfhi(unsigned u) { return __uint_as_float(u & 0xffff0000u); }
DI float sigmoidf_(float x) { return __builtin_amdgcn_rcpf(1.0f + __expf(-x)); }
DI float siluf_(float x) { return x * __builtin_amdgcn_rcpf(1.0f + __expf(-x)); }
DI float ex2(float x) { return __builtin_amdgcn_exp2f(x); }
DI s16x4 tr_read(const char* p) {
  return __builtin_amdgcn_ds_read_tr16_b64_v4i16((s16x4 __attribute__((address_space(3)))*)(p));
}
DI bf16x8 cat8(s16x4 a, s16x4 b) { return __builtin_shufflevector(a, b, 0, 1, 2, 3, 4, 5, 6, 7); }
DI bf16x8 tr_pair(const char* p, int rowstep4) { return cat8(tr_read(p), tr_read(p + rowstep4)); }
DI bf16x8 pack8(const f32x16& x, int s) {
  unsigned p0 = pk2(x[8 * s + 0], x[8 * s + 1]), p1 = pk2(x[8 * s + 2], x[8 * s + 3]);
  unsigned p2 = pk2(x[8 * s + 4], x[8 * s + 5]), p3 = pk2(x[8 * s + 6], x[8 * s + 7]);
  uint4 u = make_uint4(p0, p1, p2, p3);
  return __builtin_bit_cast(bf16x8, u);
}
DI f32x16 zero16() { f32x16 z; for (int i = 0; i < 16; ++i) z[i] = 0.f; return z; }
typedef float f32x4v __attribute__((ext_vector_type(4)));
typedef unsigned u32x2v __attribute__((ext_vector_type(2)));
DI float4 ldnt4(const float* p) { const f32x4v v = __builtin_nontemporal_load((const f32x4v*)p); return make_float4(v.x, v.y, v.z, v.w); }
DI void stnt4(float* p, float4 v) { f32x4v w = {v.x, v.y, v.z, v.w}; __builtin_nontemporal_store(w, (f32x4v*)p); }
DI uint2 ldnt2u(const u16* p) { const u32x2v v = __builtin_nontemporal_load((const u32x2v*)p); return make_uint2(v.x, v.y); }
DI float wave_sum(float v) { for (int o = 32; o >= 1; o >>= 1) v += __shfl_xor(v, o); return v; }

#define XB_TMO      128
#define XB_XCNT(j)  (256  + 64 * (j))
#define XB_XSUB(j)  (1280 + 64 * (j))
#define XB_XGEN(j)  (2304 + 64 * (j))
#define XB_TOP      3328
#define XB_TOPGEN   3392
#define XCD_BAR_WORDS 3456
#define XB_SPIN_CAP (1u << 18)
#define LAS __attribute__((address_space(3)))

__device__ __forceinline__ unsigned xb_ld(unsigned* p)              { return __hip_atomic_load(p, __ATOMIC_RELAXED, __HIP_MEMORY_SCOPE_AGENT); }
__device__ __forceinline__ unsigned xb_add(unsigned* p, unsigned v) { return __hip_atomic_fetch_add(p, v, __ATOMIC_RELAXED, __HIP_MEMORY_SCOPE_AGENT); }
__device__ __forceinline__ unsigned xb_xcc_id() { return (unsigned)__builtin_amdgcn_s_getreg((3 << 11) | 20) & 0xFu; }
#define XB_SPIN(cond, bar) do { unsigned _sp = 0; while (cond) { __builtin_amdgcn_s_sleep(1); \
    if ((++_sp & 255u) == 0u) { if (xb_ld(&(bar)[XB_TMO])) break; if (_sp > XB_SPIN_CAP) { atomicAdd(&(bar)[XB_TMO], 1u); break; } } } } while (0)

struct XcdBarrier {
    unsigned* bar; unsigned x;
    volatile LAS unsigned* st;
};

__device__ __forceinline__ XcdBarrier xcd_barrier_post(unsigned* bar, volatile LAS unsigned* st) {
    XcdBarrier b; b.bar = bar; b.x = xb_xcc_id(); b.st = st;
    if (threadIdx.x == 0) (void)xb_add(&bar[XB_XCNT(b.x)], 1u);
    return b;
}
__device__ __forceinline__ void xcd_barrier_complete(unsigned* bar, unsigned x, unsigned& nloc, unsigned& nx) {
    const unsigned G = gridDim.x * gridDim.y * gridDim.z;
    unsigned sum, cnt, mine, sp = 0u;
    for (;;) {
        sum = 0u; cnt = 0u; mine = 0u;
#pragma unroll
        for (unsigned j = 0; j < 16; ++j) { const unsigned c = xb_ld(&bar[XB_XCNT(j)]); sum += c; cnt += (c > 0u) ? 1u : 0u; mine = (j == x) ? c : mine; }
        if (sum == G) break;
        __builtin_amdgcn_s_sleep(1);
        if ((++sp & 255u) == 0u) { if (xb_ld(&bar[XB_TMO])) break; if (sp > XB_SPIN_CAP) { atomicAdd(&bar[XB_TMO], 1u); break; } }
    }
    nloc = mine > 0u ? mine : 1u; nx = cnt > 0u ? cnt : 1u;
}

__device__ __forceinline__ void xcd_barrier(const XcdBarrier& b, int tid_) {
    asm volatile("s_waitcnt vmcnt(0)" ::: "memory");
    __syncthreads();
    if (tid_ == 0) {
        unsigned* bar = b.bar;
        __builtin_amdgcn_s_waitcnt(0);
        unsigned nloc = b.st[0], nx = b.st[1];
        if (nloc == 0u) { xcd_barrier_complete(bar, b.x, nloc, nx); b.st[0] = nloc; b.st[1] = nx; }
        const unsigned old = xb_add(&bar[XB_XSUB(b.x)], 1u);
        const unsigned gen = old / nloc;
        if (old + 1u == (gen + 1u) * nloc) {
            __builtin_amdgcn_fence(__ATOMIC_RELEASE, "agent");
            asm volatile("s_waitcnt vmcnt(0)" ::: "memory");
            const unsigned og = xb_add(&bar[XB_TOP], 1u);
            const unsigned tg = og / nx;
            if (og + 1u == (tg + 1u) * nx) xb_add(&bar[XB_TOPGEN], 1u);
            else XB_SPIN(xb_ld(&bar[XB_TOPGEN]) == tg, bar);
            __builtin_amdgcn_fence(__ATOMIC_ACQUIRE, "agent");
            xb_add(&bar[XB_XGEN(b.x)], 1u);
            asm volatile("s_waitcnt vmcnt(0)" ::: "memory");
        } else {
            XB_SPIN(xb_ld(&bar[XB_XGEN(b.x)]) == gen, bar);
            __builtin_amdgcn_fence(__ATOMIC_ACQUIRE, "agent");
            asm volatile("s_waitcnt vmcnt(0)" ::: "memory");
        }
    }
    __syncthreads();
}


struct APlain {
  const u16* base; long ld;
  DI const u16* operator()(int row, int k) const { return base + (long)row * ld + k; }
};
struct ACmp {
  const u16* zb; int row0;
  DI const u16* operator()(int row, int k) const {
    int rg = row0 + row; int n = rg >> 2; if (n > 126) n = 126; int g = rg & 3;
    return zb + (long)(16 * n + (k >> 6)) * ZW + g * 64 + (k & 63);
  }
};

template <bool LOWREG = false, class AP>
DI void gemm_kloop(f32x16 (&acc)[2][2], const AP& ap, const u16* Bt, long ldb, int K, char* lds, int tid) {
  asm volatile("" : "+v"(tid));
  const int lane = tid & 63, w = tid >> 6, wm = w >> 1, wn = w & 1, r = lane & 31, h = lane >> 5;
  const int lrow = tid >> 3, lk = (tid & 7) * 8;
  const int nk = K >> 6;
#define G_LOAD(RA, RB, KT) { const int k0_ = (KT) * 64 + lk; _Pragma("unroll") for (int i = 0; i < 4; ++i) { \
      RA[i] = *(const u32x4*)ap(lrow + 32 * i, k0_); RB[i] = *(const u32x4*)(Bt + (long)(lrow + 32 * i) * ldb + k0_); } }
#define G_STORE(RA, RB, BUF) { char* lw_ = lds + (BUF) * 36864; _Pragma("unroll") for (int i = 0; i < 4; ++i) { \
      *(u32x4*)(lw_ + (lrow + 32 * i) * 144 + lk * 2) = RA[i]; *(u32x4*)(lw_ + 18432 + (lrow + 32 * i) * 144 + lk * 2) = RB[i]; } }
#define G_COMPUTE(BUF) { const char* la_ = lds + (BUF) * 36864 + (wm * 64 + r) * 144 + h * 16; \
    const char* lb_ = lds + (BUF) * 36864 + 18432 + (wn * 64 + r) * 144 + h * 16; \
    _Pragma("unroll") for (int ks = 0; ks < 4; ++ks) { \
      bf16x8 a0 = *(const bf16x8*)(la_ + ks * 32), a1 = *(const bf16x8*)(la_ + 32 * 144 + ks * 32); \
      bf16x8 b0 = *(const bf16x8*)(lb_ + ks * 32), b1 = *(const bf16x8*)(lb_ + 32 * 144 + ks * 32); \
      acc[0][0] = MFMA(b0, a0, acc[0][0]); acc[0][1] = MFMA(b1, a0, acc[0][1]); \
      acc[1][0] = MFMA(b0, a1, acc[1][0]); acc[1][1] = MFMA(b1, a1, acc[1][1]); } }
  if (LOWREG) {
    u32x4 ra[4], rb[4];
    G_LOAD(ra, rb, 0);
    G_STORE(ra, rb, 0);
    __syncthreads();
    for (int kt = 0; kt < nk; ++kt) {
      const int buf = kt & 1;
      G_COMPUTE(buf);
      if (kt + 1 < nk) { G_LOAD(ra, rb, kt + 1); G_STORE(ra, rb, buf ^ 1); }
      __syncthreads();
    }
  } else {
    u32x4 ra0[4], rb0[4], ra1[4], rb1[4];
    G_LOAD(ra0, rb0, 0);
    G_LOAD(ra1, rb1, (nk > 1 ? 1 : 0));
    G_STORE(ra0, rb0, 0);
    __syncthreads();
    for (int kt = 0; kt < nk; kt += 2) {
      G_LOAD(ra0, rb0, (kt + 2 < nk ? kt + 2 : nk - 1));
      G_COMPUTE(0);
      if (kt + 1 < nk) G_STORE(ra1, rb1, 1);
      __syncthreads();
      if (kt + 1 < nk) {
        G_LOAD(ra1, rb1, (kt + 3 < nk ? kt + 3 : nk - 1));
        G_COMPUTE(1);
        if (kt + 2 < nk) G_STORE(ra0, rb0, 0);
        __syncthreads();
      }
    }
  }
#undef G_LOAD
#undef G_STORE
#undef G_COMPUTE
}

#define EPI_M(mi) (wm * 64 + (mi) * 32 + r)
#define EPI_N(ni, i) (wn * 64 + (ni) * 32 + ((i) & 3) + 8 * ((i) >> 2) + 4 * h)

DI void store_tile_bf16(const f32x16 (&acc)[2][2], u16* dst, long ldd, char* lds, int tid, u16* halo = nullptr, int grow0 = 0) {
  asm volatile("" : "+v"(tid));
  const int lane = tid & 63, w = tid >> 6, wm = w >> 1, wn = w & 1, r = lane & 31, h = lane >> 5;
#pragma unroll
  for (int mi = 0; mi < 2; ++mi)
#pragma unroll
    for (int ni = 0; ni < 2; ++ni)
#pragma unroll
      for (int a4 = 0; a4 < 4; ++a4) {
        uint2 u; u.x = pk2(acc[mi][ni][4 * a4], acc[mi][ni][4 * a4 + 1]); u.y = pk2(acc[mi][ni][4 * a4 + 2], acc[mi][ni][4 * a4 + 3]);
        *(uint2*)(lds + EPI_M(mi) * 272 + EPI_N(ni, 4 * a4) * 2) = u;
      }
  __syncthreads();
#pragma unroll
  for (int i = 0; i < 8; ++i) {
    const int c = tid + 256 * i, row = c >> 4, cc = c & 15;
    const u32x4 v = *(const u32x4*)(lds + row * 272 + cc * 16);
    *(u32x4*)(dst + (long)row * ldd + cc * 8) = v;
    if (halo && ((row & 63) >= 61)) {
      const int grow = grow0 + row;
      *(u32x4*)(halo + ((long)(grow >> 6) * 3 + ((grow & 63) - 61)) * 1024 + cc * 8) = v;
    }
  }
  __syncthreads();
}

template <class AP>
DI void gemm_kloop64(f32x16 (&acc)[2], const AP& ap, const u16* Bt, long ldb, int K, char* lds, int tid) {
  asm volatile("" : "+v"(tid));
  const int lane = tid & 63, w = tid >> 6, wm = w >> 1, wn = w & 1, r = lane & 31, h = lane >> 5;
  const int lrow = tid >> 3, lk = (tid & 7) * 8;
  const int nk = K >> 6;
#define J_LOAD(RA, RB, KT) { const int k0_ = (KT) * 64 + lk; \
    _Pragma("unroll") for (int i = 0; i < 2; ++i) RA[i] = *(const u32x4*)ap(lrow + 32 * i, k0_); \
    _Pragma("unroll") for (int i = 0; i < 4; ++i) RB[i] = *(const u32x4*)(Bt + (long)(lrow + 32 * i) * ldb + k0_); }
#define J_STORE(RA, RB, BUF) { char* lw_ = lds + (BUF) * 27648; \
    _Pragma("unroll") for (int i = 0; i < 2; ++i) *(u32x4*)(lw_ + (lrow + 32 * i) * 144 + lk * 2) = RA[i]; \
    _Pragma("unroll") for (int i = 0; i < 4; ++i) *(u32x4*)(lw_ + 9216 + (lrow + 32 * i) * 144 + lk * 2) = RB[i]; }
#define J_COMPUTE(BUF) { const char* la_ = lds + (BUF) * 27648 + (wm * 32 + r) * 144 + h * 16; \
    const char* lb_ = lds + (BUF) * 27648 + 9216 + (wn * 64 + r) * 144 + h * 16; \
    _Pragma("unroll") for (int ks = 0; ks < 4; ++ks) { \
      bf16x8 a_ = *(const bf16x8*)(la_ + ks * 32); \
      bf16x8 b0 = *(const bf16x8*)(lb_ + ks * 32), b1 = *(const bf16x8*)(lb_ + 32 * 144 + ks * 32); \
      acc[0] = MFMA(b0, a_, acc[0]); acc[1] = MFMA(b1, a_, acc[1]); } }
  u32x4 ra0[2], rb0[4], ra1[2], rb1[4];
  J_LOAD(ra0, rb0, 0);
  J_LOAD(ra1, rb1, (nk > 1 ? 1 : 0));
  J_STORE(ra0, rb0, 0);
  __syncthreads();
  for (int kt = 0; kt < nk; kt += 2) {
    J_LOAD(ra0, rb0, (kt + 2 < nk ? kt + 2 : nk - 1));
    J_COMPUTE(0);
    if (kt + 1 < nk) J_STORE(ra1, rb1, 1);
    __syncthreads();
    if (kt + 1 < nk) {
      J_LOAD(ra1, rb1, (kt + 3 < nk ? kt + 3 : nk - 1));
      J_COMPUTE(1);
      if (kt + 2 < nk) J_STORE(ra0, rb0, 0);
      __syncthreads();
    }
  }
#undef J_LOAD
#undef J_STORE
#undef J_COMPUTE
}

template <class AP>
DI void gemm_kloop256(f32x16 (&acc)[4][2], const AP& ap, const u16* Bt, long ldb, int K, char* lds, int tid) {
  asm volatile("" : "+v"(tid));
  const int lane = tid & 63, w = tid >> 6, wm = w >> 1, wn = w & 1, r = lane & 31, h = lane >> 5;
  const int lrow = tid >> 2, lk = (tid & 3) * 8;
  const int nk = K >> 5;
#define H_LOAD(RA, RB, KT) { const int k0_ = (KT) * 32 + lk; \
    _Pragma("unroll") for (int i = 0; i < 4; ++i) RA[i] = *(const u32x4*)ap(lrow + 64 * i, k0_); \
    _Pragma("unroll") for (int i = 0; i < 2; ++i) RB[i] = *(const u32x4*)(Bt + (long)(lrow + 64 * i) * ldb + k0_); }
#define H_STORE(RA, RB, BUF) { char* lw_ = lds + (BUF) * 30720; \
    _Pragma("unroll") for (int i = 0; i < 4; ++i) *(u32x4*)(lw_ + (lrow + 64 * i) * 80 + lk * 2) = RA[i]; \
    _Pragma("unroll") for (int i = 0; i < 2; ++i) *(u32x4*)(lw_ + 20480 + (lrow + 64 * i) * 80 + lk * 2) = RB[i]; }
#define H_COMPUTE(BUF) { const char* la_ = lds + (BUF) * 30720 + (wm * 128 + r) * 80 + h * 16; \
    const char* lb_ = lds + (BUF) * 30720 + 20480 + (wn * 64 + r) * 80 + h * 16; \
    _Pragma("unroll") for (int ks = 0; ks < 2; ++ks) { \
      bf16x8 b0 = *(const bf16x8*)(lb_ + ks * 32), b1 = *(const bf16x8*)(lb_ + 32 * 80 + ks * 32); \
      _Pragma("unroll") for (int mi = 0; mi < 4; ++mi) { \
        bf16x8 a_ = *(const bf16x8*)(la_ + mi * 32 * 80 + ks * 32); \
        acc[mi][0] = MFMA(b0, a_, acc[mi][0]); acc[mi][1] = MFMA(b1, a_, acc[mi][1]); } } }
  u32x4 ra0[4], rb0[2], ra1[4], rb1[2];
  H_LOAD(ra0, rb0, 0);
  H_LOAD(ra1, rb1, (nk > 1 ? 1 : 0));
  H_STORE(ra0, rb0, 0);
  __syncthreads();
  for (int kt = 0; kt < nk; kt += 2) {
    H_LOAD(ra0, rb0, (kt + 2 < nk ? kt + 2 : nk - 1));
    H_COMPUTE(0);
    if (kt + 1 < nk) H_STORE(ra1, rb1, 1);
    __syncthreads();
    if (kt + 1 < nk) {
      H_LOAD(ra1, rb1, (kt + 3 < nk ? kt + 3 : nk - 1));
      H_COMPUTE(1);
      if (kt + 2 < nk) H_STORE(ra0, rb0, 0);
      __syncthreads();
    }
  }
#undef H_LOAD
#undef H_STORE
#undef H_COMPUTE
}
#define EPI_M4(mi) (wm * 128 + (mi) * 32 + r)

DI void store_tile256_bf16(const f32x16 (&acc)[4][2], u16* dst, long ldd, char* lds, int tid, u16* halo = nullptr, int grow0 = 0) {
  asm volatile("" : "+v"(tid));
  const int lane = tid & 63, w = tid >> 6, wm = w >> 1, wn = w & 1, r = lane & 31, h = lane >> 5;
#pragma unroll
  for (int mi = 0; mi < 4; ++mi)
#pragma unroll
    for (int ni = 0; ni < 2; ++ni)
#pragma unroll
      for (int a4 = 0; a4 < 4; ++a4) {
        uint2 u; u.x = pk2(acc[mi][ni][4 * a4], acc[mi][ni][4 * a4 + 1]); u.y = pk2(acc[mi][ni][4 * a4 + 2], acc[mi][ni][4 * a4 + 3]);
        *(uint2*)(lds + EPI_M4(mi) * 272 + EPI_N(ni, 4 * a4) * 2) = u;
      }
  __syncthreads();
#pragma unroll
  for (int i = 0; i < 16; ++i) {
    const int c = tid + 256 * i, row = c >> 4, cc = c & 15;
    const u32x4 v = *(const u32x4*)(lds + row * 272 + cc * 16);
    *(u32x4*)(dst + (long)row * ldd + cc * 8) = v;
    if (halo && ((row & 63) >= 61)) {
      const int grow = grow0 + row;
      *(u32x4*)(halo + ((long)(grow >> 6) * 3 + ((grow & 63) - 61)) * 1024 + cc * 8) = v;
    }
  }
  __syncthreads();
}

DI bool tile_xcd(int it, int n_mt, int n_nt, int& mt, int& nt) {
  const int x = blockIdx.x & 7, loc = blockIdx.x >> 3, nloc = gridDim.x >> 3;
  const int rt = n_mt >> 3;
  const int i = loc + it * nloc;
  if (i >= rt * n_nt) return false;
  mt = x * rt + (i % rt); nt = i / rt;
  return true;
}

DI int win_src_col(int n) {
  if (n < 2560) return n;
  if (n < 4096) return n - 2560 + 2608;
  if (n < 4608) return n - 4096 + 4152;
  if (n < 5120) return n - 4608 + 4664;
  if (n < 5248) { int c = n - 5120; if (c < 48) return 2560 + c; if (c < 56) return 4144 + (c - 48); return -1; }
  return n - 5248 + 5176;
}
DI int ff_src_col(int n) { int blk = n >> 6, w = n & 63; return (w < 32) ? (blk * 32 + w) : (2816 + blk * 32 + (w - 32)); }

DI void transpose_tile(const float* src, int Nsrc, u16* dst, int K, int k0, int n0, int map, float* tile, int tid) {
  {
    const int n4 = (tid & 15) * 4, kb = tid >> 4;
    const int n = n0 + n4;
    const int sc = (map == 0) ? n : (map == 1 ? win_src_col(n) : ff_src_col(n));
    float4 v[4];
#pragma unroll
    for (int i = 0; i < 4; ++i) v[i] = (sc >= 0) ? ldnt4(src + (long)(k0 + kb + 16 * i) * Nsrc + sc) : make_float4(0.f, 0.f, 0.f, 0.f);
#pragma unroll
    for (int i = 0; i < 4; ++i) *(float4*)(tile + (kb + 16 * i) * 68 + n4) = v[i];
  }
  __syncthreads();
  {
#pragma unroll
    for (int i = 0; i < 2; ++i) {
      const int item = tid + 256 * i, nn = item & 63, k8 = (item >> 6) * 8;
      float f[8];
#pragma unroll
      for (int j = 0; j < 8; ++j) f[j] = tile[(k8 + j) * 68 + nn];
      u32x4 u;
      u.x = pk2(f[0], f[1]); u.y = pk2(f[2], f[3]); u.z = pk2(f[4], f[5]); u.w = pk2(f[6], f[7]);
      *(u32x4*)(dst + (long)(n0 + nn) * K + k0 + k8) = u;
    }
  }
  __syncthreads();
}

DI void rmsnorm_row_bf16(const float* src, const float* g, u16* dst, int lane) {
  float4 v[4]; float ss = 0.f;
#pragma unroll
  for (int i = 0; i < 4; ++i) { v[i] = ((const float4*)src)[lane + 64 * i]; ss += v[i].x * v[i].x + v[i].y * v[i].y + v[i].z * v[i].z + v[i].w * v[i].w; }
  ss = wave_sum(ss);
  const float rn = rsqrtf(ss * (1.0f / 1024.0f) + 1e-6f);
#pragma unroll
  for (int i = 0; i < 4; ++i) {
    float4 gg = ((const float4*)g)[lane + 64 * i];
    uint2 o; o.x = pk2(v[i].x * rn * gg.x, v[i].y * rn * gg.y); o.y = pk2(v[i].z * rn * gg.z, v[i].w * rn * gg.w);
    ((uint2*)dst)[lane + 64 * i] = o;
  }
}

DI bool transpose_job(const Params& p, int t, int set, float* tile, int tid) {
  int rem = t;
  const float* src = nullptr; u16* dst = nullptr; int Nsrc = 0, K = 0, Nd = 0, map = 0;
  bool found = false;
  for (int j = 0; j < 6; ++j) {
    if (set == 0) {
      if (j >= 4) break;
      switch (j) {
        case 0: src = p.w_in; Nsrc = 8248; dst = p.WinT; K = 1024; Nd = 8320; map = 1; break;
        case 1: src = p.w_mem_kv; Nsrc = 1024; dst = p.WmkvT; K = 1024; Nd = 1024; map = 0; break;
        case 2: src = p.w1_k; Nsrc = 128; dst = p.W1kT; K = 2048; Nd = 128; map = 0; break;
        default: src = p.w1_v; Nsrc = 128; dst = p.W1vT; K = 2048; Nd = 128; map = 0; break;
      }
    } else {
      switch (j) {
        case 0: src = p.w_ffin; Nsrc = 5632; dst = p.WffT; K = 1024; Nd = 5632; map = 2; break;
        case 1: src = p.w_ffdn; Nsrc = 1024; dst = p.WdnT; K = 2816; Nd = 1024; map = 0; break;
        case 2: src = p.w_pn; Nsrc = 1024; dst = p.WpnT; K = 1024; Nd = 1024; map = 0; break;
        case 3: src = p.w_pml; Nsrc = 1024; dst = p.WpmlT; K = 512; Nd = 1024; map = 0; break;
        case 4: src = p.w_pmem; Nsrc = 1024; dst = p.WpmemT; K = 512; Nd = 1024; map = 0; break;
        default: src = p.w_out; Nsrc = 1024; dst = p.WoutT; K = 1024; Nd = 1024; map = 0; break;
      }
    }
    const int nt = (Nd >> 6) * (K >> 6);
    if (rem < nt) { found = true; break; }
    rem -= nt;
  }
  if (!found) return false;
  const int kt = K >> 6;
  transpose_tile(src, Nsrc, dst, K, (rem % kt) * 64, (rem / kt) * 64, map, tile, tid);
  return true;
}

DI void phase_prep(const Params& p, char* lds, int tid) {
  float* tile = (float*)lds;
  if (blockIdx.x == 0 && tid == 0) { int* c_ = p.ctr; asm volatile("" : "+s"(c_)); __hip_atomic_store(c_ + 0, 0, __ATOMIC_RELAXED, __HIP_MEMORY_SCOPE_AGENT); __hip_atomic_store(c_ + 1, 0, __ATOMIC_RELAXED, __HIP_MEMORY_SCOPE_AGENT); __hip_atomic_store(c_ + 2, 0, __ATOMIC_RELAXED, __HIP_MEMORY_SCOPE_AGENT); }
  if (blockIdx.x == 1 && tid < 32) __hip_atomic_store(p.ctr + 32 + tid, 0, __ATOMIC_RELAXED, __HIP_MEMORY_SCOPE_AGENT);
  for (int t = blockIdx.x;; t += gridDim.x) {
    if (!transpose_job(p, t, 0, tile, tid)) break;
  }
  {
    const int lane = tid & 63, w = tid >> 6;
    const int stride = gridDim.x * 4;
    for (int row0 = blockIdx.x * 4 + w; row0 < T_TOK + 2048; row0 += 3 * stride) {
      float4 v[3][4];
#pragma unroll
      for (int k = 0; k < 3; ++k) {
        const int row = (row0 + k * stride < T_TOK + 2048) ? row0 + k * stride : row0;
        const float* sp = (row < T_TOK) ? p.x + (long)row * 1024 : p.mem + (long)(row - T_TOK) * 1024;
#pragma unroll
        for (int i = 0; i < 4; ++i) v[k][i] = ldnt4(sp + 4 * (lane + 64 * i));
      }
#pragma unroll
      for (int k = 0; k < 3; ++k) {
        const int row = row0 + k * stride;
        if (row < T_TOK + 2048) {
          const float* g = (row < T_TOK) ? p.g_pre_mix : p.g_mem;
          u16* dp = (row < T_TOK) ? p.hbuf + (long)row * 1024 : p.memn + (long)(row - T_TOK) * 1024;
          float ss = 0.f;
#pragma unroll
          for (int i = 0; i < 4; ++i) ss += v[k][i].x * v[k][i].x + v[k][i].y * v[k][i].y + v[k][i].z * v[k][i].z + v[k][i].w * v[k][i].w;
          const float rn = rsqrtf(wave_sum(ss) * (1.0f / 1024.0f) + 1e-6f);
#pragma unroll
          for (int i = 0; i < 4; ++i) {
            const float4 gg = ((const float4*)g)[lane + 64 * i];
            uint2 o; o.x = pk2(v[k][i].x * rn * gg.x, v[k][i].y * rn * gg.y); o.y = pk2(v[k][i].z * rn * gg.z, v[k][i].w * rn * gg.w);
            ((uint2*)dp)[lane + 64 * i] = o;
          }
        }
      }
    }
  }
  if (blockIdx.x < 32) {
    const int side = blockIdx.x >> 4, part = blockIdx.x & 15;
    const float* pe = side ? p.pe_v : p.pe_k;
    const float* w1 = side ? p.w1_v : p.w1_k;
    const int hc = tid & 127, half = tid >> 7;
    const int kk0 = part * 128 + half * 64;
    float s = 0.f;
#pragma unroll 16
    for (int kk = kk0; kk < kk0 + 64; ++kk) s += pe[kk] * w1[(long)kk * 128 + hc];
    __syncthreads();
    tile[tid] = s;
    __syncthreads();
    if (tid < 128) p.cbias[256 + (side * 16 + part) * 128 + tid] = tile[tid] + tile[tid + 128];
    __syncthreads();
  }
}

DI void phase_gemm_in(const Params& p, char* lds, int tid) {
  if (blockIdx.x == gridDim.x - 1) {
    const int side = tid >> 7, hc = tid & 127;
    float s = 0.f;
    for (int part = 0; part < 16; ++part) s += p.cbias[256 + (side * 16 + part) * 128 + hc];
    p.cbias[tid] = s;
  }
  for (int it = 0;; ++it) {
    int mt, nt;
    if (!tile_xcd(it, 128, 41, mt, nt)) break;
    f32x16 acc[2][2];
    for (int a = 0; a < 2; ++a) for (int b = 0; b < 2; ++b) acc[a][b] = zero16();
    gemm_kloop(acc, APlain{p.hbuf + (long)mt * 128 * 1024, 1024}, p.WinT + (long)nt * 128 * 1024, 1024, 1024, lds, tid);
    const long m0 = (long)mt * 128;
    if (nt < 40) {
      store_tile_bf16(acc, p.z + m0 * ZW + nt * 128, ZW, lds, tid, (nt >= 20 && nt < 28) ? p.halo + (nt - 20) * 128 : nullptr, (int)m0);
    } else {
      int t3 = tid;
      asm volatile("" : "+v"(t3));
      const int wm = (t3 >> 7) & 1, wn = (t3 >> 6) & 1, r = t3 & 31, h = (t3 >> 5) & 1;
      float* gl = (float*)lds;
      if (wn == 0) {
#pragma unroll
        for (int mi = 0; mi < 2; ++mi)
#pragma unroll
          for (int ni = 0; ni < 2; ++ni)
#pragma unroll
            for (int a4 = 0; a4 < 4; ++a4) {
              const float4 v4 = make_float4(acc[mi][ni][4 * a4], acc[mi][ni][4 * a4 + 1], acc[mi][ni][4 * a4 + 2], acc[mi][ni][4 * a4 + 3]);
              *(float4*)(p.zf + (m0 + EPI_M(mi)) * 64 + EPI_N(ni, 4 * a4)) = v4;
              if (ni == 1 && a4 == 2) *(float4*)(gl + EPI_M(mi) * 8 + 4 * h) = v4;
            }
      }
      __syncthreads();
      {
        const int lane2 = t3 & 63, w2 = t3 >> 6;
        const int crow0 = (w2 >> 1) * 64;
        const long grow = m0 + crow0;
        const int bb = (int)(grow >> 11), cc = (int)((grow & 2047) >> 6);
#pragma unroll
        for (int hq = 0; hq < 2; ++hq) {
          const int hh = (w2 & 1) * 2 + hq;
          const float ig = gl[(crow0 + lane2) * 8 + hh] + p.gate_b[hh], fg = gl[(crow0 + lane2) * 8 + 4 + hh] + p.gate_b[4 + hh];
          const float lf = fminf(fg, 0.f) - log1pf(__expf(-fabsf(fg)));
          float bs = lf;
#pragma unroll
          for (int o = 1; o < 64; o <<= 1) { const float t = __shfl_up(bs, o); if (lane2 >= o) bs += t; }
          float cm = ig - bs;
#pragma unroll
          for (int o = 1; o < 64; o <<= 1) { const float t = __shfl_up(cm, o); if (lane2 >= o) cm = fmaxf(cm, t); }
          if (lane2 == 63) { const int task = (bb * 4 + hh) * 32 + cc; p.mlba[task * 2] = bs; p.mlba[task * 2 + 1] = cm; }
        }
      }
      __syncthreads();
    }
  }
  {
    const int xg = blockIdx.x & 7, loc = blockIdx.x >> 3, nloc = gridDim.x >> 3;
    const bool spread = nloc >= 32;
    for (int t = spread ? ((loc >= 16 && loc < 32) ? xg * 16 + (loc - 16) : 128) : (int)blockIdx.x; t < 128; t += spread ? 128 : (int)gridDim.x) {
      const int mt = t >> 3, nt = t & 7;
      f32x16 acc[2][2];
      for (int a = 0; a < 2; ++a) for (int b = 0; b < 2; ++b) acc[a][b] = zero16();
      gemm_kloop(acc, APlain{p.memn + (long)mt * 128 * 1024, 1024}, p.WmkvT + (long)nt * 128 * 1024, 1024, 1024, lds, tid);
      store_tile_bf16(acc, p.kvm + (long)mt * 128 * 1024 + nt * 128, 1024, lds, tid);
    }
  }
  {
    int* sh_item = (int*)(lds + LDS_BYTES + 32);
    while (true) {
      if (tid == 0) *sh_item = atomicAdd(p.ctr + 2, 1);
      __syncthreads();
      const int t = *sh_item;
      __syncthreads();
      if (!transpose_job(p, t, 1, (float*)lds, tid)) break;
    }
  }
}

DI void compress_item(const Params& p, int it, char* lds, int tid) {
  const int lane = tid & 63, w = tid >> 6, wm = w >> 1, wn = w & 1, r = lane & 31, h = lane >> 5;
  const int side = it >> 6, b = (it >> 3) & 7, rt = it & 7;
  f32x16 acc[2];
  acc[0] = zero16(); acc[1] = zero16();
  ACmp ap{p.z + (long)b * 2048 * ZW + 1024 + side * 256, rt * 64};
  gemm_kloop64(acc, ap, side ? p.W1vT : p.W1kT, 2048, 2048, lds, tid);
  u16* hid = (u16*)lds;
  float* w2s = (float*)(lds + 17408);
  const float* cb = p.cbias + side * 128;
#pragma unroll
  for (int ni = 0; ni < 2; ++ni)
#pragma unroll
    for (int a4 = 0; a4 < 4; ++a4) {
      const float4 bb = *(const float4*)(cb + EPI_N(ni, 4 * a4));
      uint2 u;
      u.x = pk2(siluf_(acc[ni][4 * a4] + bb.x), siluf_(acc[ni][4 * a4 + 1] + bb.y));
      u.y = pk2(siluf_(acc[ni][4 * a4 + 2] + bb.z), siluf_(acc[ni][4 * a4 + 3] + bb.w));
      *(uint2*)(hid + (wm * 32 + r) * 136 + EPI_N(ni, 4 * a4)) = u;
    }
  const float* w2 = side ? p.w2_v : p.w2_k;
  for (int i = tid; i < 2048; i += 256) ((float4*)w2s)[i] = ((const float4*)w2)[i];
  __syncthreads();
  {
    const int row = tid >> 2, dh0 = (tid & 3) * 16;
    float o[16];
#pragma unroll
    for (int d = 0; d < 16; ++d) o[d] = 0.f;
#pragma unroll 4
    for (int hh = 0; hh < 128; ++hh) {
      const float hv = bf2f(hid[row * 136 + hh]);
      const float4* wr = (const float4*)(w2s + hh * 64 + dh0);
#pragma unroll
      for (int d4 = 0; d4 < 4; ++d4) { float4 ww = wr[d4]; o[4 * d4] += hv * ww.x; o[4 * d4 + 1] += hv * ww.y; o[4 * d4 + 2] += hv * ww.z; o[4 * d4 + 3] += hv * ww.w; }
    }
    const int rg = rt * 64 + row, n = rg >> 2, g = rg & 3;
    const float keep = (n < 127) ? 1.f : 0.f;
    u16* dst = (side ? p.vc : p.kc) + ((long)((b * 4 + g) * 128 + n)) * 64 + dh0;
#pragma unroll
    for (int d8 = 0; d8 < 2; ++d8) {
      u32x4 u;
      u.x = pk2(o[8 * d8] * keep, o[8 * d8 + 1] * keep); u.y = pk2(o[8 * d8 + 2] * keep, o[8 * d8 + 3] * keep);
      u.z = pk2(o[8 * d8 + 4] * keep, o[8 * d8 + 5] * keep); u.w = pk2(o[8 * d8 + 6] * keep, o[8 * d8 + 7] * keep);
      ((u32x4*)dst)[d8] = u;
    }
  }
  __syncthreads();
}

template <int NE> struct AttnState { f32x16 o[NE]; float m, l; };
template <int NE> DI void attn_init(AttnState<NE>& st) {
#pragma unroll
  for (int e = 0; e < NE; ++e) st.o[e] = zero16();
  st.m = -1e30f; st.l = 0.f;
}

template <int DH, bool EMIT, int NE, int E0, class MF>
DI void attn_sweep(AttnState<NE>& st, const bf16x8 (&qf)[DH / 16], const u16* Kb, const u16* Vb, long stride, int t_first, int t_last,
                   unsigned tmask, float sc, MF mf, char* lds, int tid, float* psum, float il) {
  constexpr int STR = (DH + 8) * 2;
  constexpr int TB = 64 * STR;
  constexpr int NCH = DH / 32;
  constexpr int CPR = DH / 8;
  const int lane = tid & 63, w = tid >> 6, r = lane & 31, h = lane >> 5;
  const int i16 = lane & 15, tq = i16 >> 2, tp = i16 & 3, blk = (lane >> 4) & 1;
  asm volatile("" : "+s"(t_last));
  int j = t_first;
  while (j <= t_last && !((tmask >> j) & 1u)) ++j;
  if (j > t_last) return;
  u32x4 kr[NCH], vr[NCH];
#pragma unroll
  for (int i = 0; i < NCH; ++i) {
    const int c = tid + 256 * i, row = c / CPR, cc = c % CPR;
    const long off = (long)(j * 64 + row) * stride + cc * 8;
    kr[i] = *(const u32x4*)(Kb + off);
    if (!EMIT) vr[i] = *(const u32x4*)(Vb + off);
  }
  int buf = 0;
  while (true) {
    {
      char* base = lds + buf * 2 * TB;
#pragma unroll
      for (int i = 0; i < NCH; ++i) {
        const int c = tid + 256 * i, row = c / CPR, cc = c % CPR;
        *(u32x4*)(base + row * STR + cc * 16) = kr[i];
        if (!EMIT) *(u32x4*)(base + TB + row * STR + cc * 16) = vr[i];
      }
    }
    __syncthreads();
    int jn = j + 1;
    while (jn <= t_last && !((tmask >> jn) & 1u)) ++jn;
    if (true) {
      const int jl = (jn <= t_last) ? jn : j;
#pragma unroll
      for (int i = 0; i < NCH; ++i) {
        const int c = tid + 256 * i, row = c / CPR, cc = c % CPR;
        const long off = (long)(jl * 64 + row) * stride + cc * 8;
        kr[i] = *(const u32x4*)(Kb + off);
        if (!EMIT) vr[i] = *(const u32x4*)(Vb + off);
      }
    }
    const char* kl = lds + buf * 2 * TB;
    const char* vl = kl + TB;
    f32x16 s[2];
#pragma unroll
    for (int mt = 0; mt < 2; ++mt) {
      s[mt] = zero16();
#pragma unroll
      for (int ks = 0; ks < DH / 16; ++ks) {
        bf16x8 a = *(const bf16x8*)(kl + (32 * mt + r) * STR + (16 * ks + 8 * h) * 2);
        s[mt] = MFMA(a, qf[ks], s[mt]);
      }
    }
    const int kbase = j * 64;
    if (!EMIT) {
      float mx = -3.0e38f;
#pragma unroll
      for (int mt = 0; mt < 2; ++mt)
#pragma unroll
        for (int i = 0; i < 16; ++i) {
          const int key = kbase + 32 * mt + (i & 3) + 8 * (i >> 2) + 4 * h;
          const float v = mf(key) ? s[mt][i] * sc : -INFINITY;
          s[mt][i] = v; mx = fmaxf(mx, v);
        }
      mx = fmaxf(mx, __shfl_xor(mx, 32));
      const float m_new = fmaxf(st.m, mx);
      const float alpha = ex2(st.m - m_new);
      float rs = 0.f;
#pragma unroll
      for (int mt = 0; mt < 2; ++mt)
#pragma unroll
        for (int i = 0; i < 16; ++i) { const float pv = ex2(s[mt][i] - m_new); s[mt][i] = pv; rs += pv; }
      rs += __shfl_xor(rs, 32);
      st.l = st.l * alpha + rs; st.m = m_new;
#pragma unroll
      for (int e = 0; e < NE; ++e)
#pragma unroll
        for (int i = 0; i < 16; ++i) st.o[e][i] *= alpha;
      bf16x8 pf[2][2];
#pragma unroll
      for (int mt = 0; mt < 2; ++mt) { pf[mt][0] = pack8(s[mt], 0); pf[mt][1] = pack8(s[mt], 1); }
#pragma unroll
      for (int e = 0; e < NE; ++e)
#pragma unroll
        for (int mt = 0; mt < 2; ++mt)
#pragma unroll
          for (int s2 = 0; s2 < 2; ++s2) {
            const char* vp = vl + (32 * mt + 16 * s2 + 4 * h + tq) * STR + (32 * (e + E0) + 16 * blk + 4 * tp) * 2;
            bf16x8 a = tr_pair(vp, 8 * STR);
            st.o[e] = MFMA(a, pf[mt][s2], st.o[e]);
          }
    } else {
#pragma unroll
      for (int mt = 0; mt < 2; ++mt)
#pragma unroll
        for (int i = 0; i < 16; ++i) {
          const int key = kbase + 32 * mt + (i & 3) + 8 * (i >> 2) + 4 * h;
          s[mt][i] = mf(key) ? ex2(s[mt][i] * sc - st.m) * il : 0.f;
        }
      for (int ww = 0; ww < 4; ++ww) {
        if (w == ww) {
#pragma unroll
          for (int mt = 0; mt < 2; ++mt)
#pragma unroll
            for (int a4 = 0; a4 < 4; ++a4) {
              float4* pp = (float4*)(psum + r * 132 + kbase + 32 * mt + 8 * a4 + 4 * h);
              float4 v = *pp;
              v.x += s[mt][4 * a4]; v.y += s[mt][4 * a4 + 1]; v.z += s[mt][4 * a4 + 2]; v.w += s[mt][4 * a4 + 3];
              *pp = v;
            }
        }
        __syncthreads();
      }
    }
    if (jn > t_last) break;
    j = jn; buf ^= 1;
    if (false) {
#pragma unroll
      for (int i = 0; i < NCH; ++i) {
        const int c = tid + 256 * i, row = c / CPR, cc = c % CPR;
        const long off = (long)(j * 64 + row) * stride + cc * 8;
        kr[i] = *(const u32x4*)(Kb + off);
        if (!EMIT) vr[i] = *(const u32x4*)(Vb + off);
      }
    }
  }
  __syncthreads();
}

struct MaskSlc { int tq, qblk; unsigned mask;
  DI bool need_elem(int j) const { return j == qblk; }
  DI bool row_ok(int j) const { return (mask >> j) & 1u; }
  DI bool elem_ok(int pos) const { return ((mask >> (pos >> 6)) & 1u) && (pos <= tq); } };
struct MaskWin { int tq, qblk, t0;
  DI bool need_elem(int j) const { return (j == qblk) || (64 * j < t0 - 480); }
  DI bool row_ok(int) const { return true; }
  DI bool elem_ok(int pos) const { return (pos <= tq) && (pos > tq - 512); } };
typedef float f32x2 __attribute__((ext_vector_type(2)));

template <class MF>
DI void attn_sweep_pf2(AttnState<2>& st, const bf16x8 (&qf)[4], const u16* Kb, const u16* Vb, long stride, int t_first, int t_last,
                       unsigned tmask, float sc, MF mf, char* lds, int tid) {
  constexpr int STR = 144, TB = 64 * STR;
  const int lane = tid & 63, r = lane & 31, h = lane >> 5;
  const int i16 = lane & 15, tq = i16 >> 2, tp = i16 & 3, blk = (lane >> 4) & 1;
  asm volatile("" : "+s"(t_last));
  const int lrow0 = tid >> 3, lcc = tid & 7;
  auto next_active = [&](int j) { while (j <= t_last && !((tmask >> j) & 1u)) ++j; return j; };
  int cur = next_active(t_first);
  if (cur > t_last) return;
  int nxt = next_active(cur + 1);
  u32x4 k0[2], v0[2];
#define A_LOAD(KR, VR, JT) { _Pragma("unroll") for (int i = 0; i < 2; ++i) { const long off_ = (long)((JT) * 64 + lrow0 + 32 * i) * stride + lcc * 8; \
      KR[i] = *(const u32x4*)(Kb + off_); VR[i] = *(const u32x4*)(Vb + off_); } }
#define A_STORE(KR, VR, BUF) { char* base_ = lds + (BUF) * 2 * TB; _Pragma("unroll") for (int i = 0; i < 2; ++i) { \
      *(u32x4*)(base_ + (lrow0 + 32 * i) * STR + lcc * 16) = KR[i]; *(u32x4*)(base_ + TB + (lrow0 + 32 * i) * STR + lcc * 16) = VR[i]; } }
  auto compute = [&](int j, int bufi) __attribute__((always_inline)) {
    const char* kl = lds + bufi * 2 * TB;
    const char* vl = kl + TB;
    f32x16 s[2];
#pragma unroll
    for (int mt = 0; mt < 2; ++mt) {
      s[mt] = zero16();
#pragma unroll
      for (int ks = 0; ks < 4; ++ks) {
        bf16x8 a = *(const bf16x8*)(kl + (32 * mt + r) * STR + (16 * ks + 8 * h) * 2);
        s[mt] = MFMA(a, qf[ks], s[mt]);
      }
    }
    const int kbase = j * 64;
    float m_new, alpha, rs;
    if (mf.need_elem(j)) {
      float mx = -3.0e38f;
#pragma unroll
      for (int mt = 0; mt < 2; ++mt)
#pragma unroll
        for (int i = 0; i < 16; ++i) {
          const int key = kbase + 32 * mt + (i & 3) + 8 * (i >> 2) + 4 * h;
          const float v = mf.elem_ok(key) ? s[mt][i] * sc : -INFINITY;
          s[mt][i] = v; mx = fmaxf(mx, v);
        }
      mx = fmaxf(mx, __shfl_xor(mx, 32));
      m_new = fmaxf(st.m, mx);
      alpha = ex2(st.m - m_new);
      rs = 0.f;
#pragma unroll
      for (int mt = 0; mt < 2; ++mt)
#pragma unroll
        for (int i = 0; i < 16; ++i) { const float pv = ex2(s[mt][i] - m_new); s[mt][i] = pv; rs += pv; }
    } else {
      const bool rok = mf.row_ok(j);
      float mr = fmaxf(s[0][0], s[1][0]);
#pragma unroll
      for (int i = 1; i < 16; ++i) mr = fmaxf(fmaxf(mr, s[0][i]), s[1][i]);
      mr = fmaxf(mr, __shfl_xor(mr, 32));
      const float mx = rok ? mr * sc : -INFINITY;
      m_new = fmaxf(st.m, mx);
      alpha = ex2(st.m - m_new);
      const float scl = rok ? sc : 0.f, off = rok ? -m_new : -INFINITY;
      f32x2 rs2 = {0.f, 0.f};
#pragma unroll
      for (int mt = 0; mt < 2; ++mt)
#pragma unroll
        for (int i2 = 0; i2 < 8; ++i2) {
          f32x2 v = {s[mt][2 * i2], s[mt][2 * i2 + 1]};
          v = v * scl + off;
          v.x = ex2(v.x); v.y = ex2(v.y);
          s[mt][2 * i2] = v.x; s[mt][2 * i2 + 1] = v.y;
          rs2 += v;
        }
      rs = rs2.x + rs2.y;
    }
    rs += __shfl_xor(rs, 32);
    st.l = st.l * alpha + rs; st.m = m_new;
#pragma unroll
    for (int e = 0; e < 2; ++e)
#pragma unroll
      for (int i2 = 0; i2 < 8; ++i2) {
        f32x2 ov = {st.o[e][2 * i2], st.o[e][2 * i2 + 1]};
        ov = ov * alpha;
        st.o[e][2 * i2] = ov.x; st.o[e][2 * i2 + 1] = ov.y;
      }
    bf16x8 pf[2][2];
#pragma unroll
    for (int mt = 0; mt < 2; ++mt) { pf[mt][0] = pack8(s[mt], 0); pf[mt][1] = pack8(s[mt], 1); }
#pragma unroll
    for (int e = 0; e < 2; ++e)
#pragma unroll
      for (int mt = 0; mt < 2; ++mt)
#pragma unroll
        for (int s2 = 0; s2 < 2; ++s2) {
          const char* vp = vl + (32 * mt + 16 * s2 + 4 * h + tq) * STR + (32 * e + 16 * blk + 4 * tp) * 2;
          bf16x8 a = tr_pair(vp, 8 * STR);
          st.o[e] = MFMA(a, pf[mt][s2], st.o[e]);
        }
  };
  A_LOAD(k0, v0, cur);
  int bufi = 0;
  while (true) {
    A_STORE(k0, v0, bufi);
    __syncthreads();
    const int nn = (nxt <= t_last) ? next_active(nxt + 1) : nxt;
    A_LOAD(k0, v0, (nxt <= t_last ? nxt : cur));
    compute(cur, bufi);
    if (nxt > t_last) break;
    cur = nxt; nxt = nn; bufi ^= 1;
  }
#undef A_LOAD
#undef A_STORE
  __syncthreads();
}

DI void nsa_item(const Params& p, int b, int g, int qt, char* lds, int tid) {
  const int lane = tid & 63, w = tid >> 6, r = lane & 31, h = lane >> 5;
  const int t0 = qt * 32, qblk = t0 >> 6, tqry = t0 + r;
  const long tok = (long)b * 2048 + tqry;
  const int head = g * 4 + w;
  float* psum = (float*)(lds + 36864);
  float* impv = (float*)(lds + 36864 + 16896);
  unsigned* selm = (unsigned*)(lds + 36864 + 16896 + 4224);
  if (qblk >= 16) {
    for (int i = tid; i < 32 * 132; i += 256) psum[i] = 0.f;
    if (tid < 32) selm[tid] = 0u;
  }
  bf16x8 qf[4];
  {
    const u16* qp = p.z + tok * ZW + head * 64 + 8 * h;
#pragma unroll
    for (int ks = 0; ks < 4; ++ks) qf[ks] = *(const bf16x8*)(qp + 16 * ks);
  }
  const float* gp = p.zf + tok * 64 + head * 3;
  const float g0 = sigmoidf_(gp[0]), g1 = sigmoidf_(gp[1]), g2 = sigmoidf_(gp[2]);
  const float sc = 0.125f * 1.4426950408889634f;
  unsigned ypk[2][8];
#pragma unroll
  for (int e = 0; e < 2; ++e)
#pragma unroll
    for (int i = 0; i < 8; ++i) ypk[e][i] = 0u;
  AttnState<2> st;
  const u16* kcb = p.kc + (long)(b * 4 + g) * 128 * 64;
  const u16* vcb = p.vc + (long)(b * 4 + g) * 128 * 64;
  auto mf_cmp = [&](int n) { return 16 * n + 31 <= tqry; };
  attn_init(st);
  attn_sweep<64, false, 2, 0>(st, qf, kcb, vcb, 64, 0, 1, 0xffffffffu, sc, mf_cmp, lds, tid, nullptr, 0.f);
  {
    const float il = st.l > 0.f ? 1.0f / st.l : 0.f;
    const float f = g0 * il;
#pragma unroll
    for (int e = 0; e < 2; ++e)
#pragma unroll
      for (int i = 0; i < 8; ++i) ypk[e][i] = pk2(bflo(ypk[e][i]) + f * st.o[e][2 * i], bfhi(ypk[e][i]) + f * st.o[e][2 * i + 1]);
    if (qblk >= 16) attn_sweep<64, true, 2, 0>(st, qf, kcb, vcb, 64, 0, 1, 0xffffffffu, sc, mf_cmp, lds, tid, psum, il);
  }
  unsigned mymask;
  if (qblk >= 16) {
    __syncthreads();
    {
      const int qq = tid >> 3, jb = (tid & 7) * 4;
      const float* P = psum + qq * 132;
#pragma unroll
      for (int jj = 0; jj < 4; ++jj) {
        const int j = jb + jj;
        float v = P[4 * j] + P[4 * j + 1] + P[4 * j + 2] + 0.5f * P[4 * j + 3];
        if (j > 0) v += 0.5f * P[4 * j - 1];
        impv[qq * 33 + j] = v;
      }
    }
    __syncthreads();
    {
      const int qq = tid >> 3, jb = (tid & 7) * 4;
      const float* I = impv + qq * 33;
      const int hi = qblk - 2;
      unsigned bits = 0u;
      for (int jj = 0; jj < 4; ++jj) {
        const int j = jb + jj;
        if (j >= 1 && j <= hi) {
          const float v = I[j];
          int rank = 0;
          for (int i = 1; i <= hi; ++i) { const float u = I[i]; rank += ((u > v) || (u == v && i < j)) ? 1 : 0; }
          if (rank < 13) bits |= (1u << j);
        }
      }
      if (bits) atomicOr(&selm[qq], bits);
    }
    __syncthreads();
    mymask = selm[r] | 1u | (1u << (qblk - 1)) | (1u << qblk);
  } else {
    mymask = (2u << qblk) - 1u;
  }
  unsigned um = mymask;
  for (int o = 16; o >= 1; o >>= 1) um |= __shfl_xor(um, o);
  um = __builtin_amdgcn_readfirstlane(um);
  {
    const u16* kb = p.z + (long)b * 2048 * ZW + 1024 + 2 * 256 + g * 64;
    const u16* vb = kb + 256;
    const MaskSlc mf{tqry, qblk, mymask};
    attn_init(st);
    attn_sweep_pf2(st, qf, kb, vb, ZW, 0, qblk, um, sc, mf, lds, tid);
    const float f = g1 * (st.l > 0.f ? 1.0f / st.l : 0.f);
#pragma unroll
    for (int e = 0; e < 2; ++e)
#pragma unroll
      for (int i = 0; i < 8; ++i) ypk[e][i] = pk2(bflo(ypk[e][i]) + f * st.o[e][2 * i], bfhi(ypk[e][i]) + f * st.o[e][2 * i + 1]);
  }
  {
    const u16* kb = p.z + (long)b * 2048 * ZW + 1024 + 4 * 256 + g * 64;
    const u16* vb = kb + 256;
    const MaskWin mf{tqry, qblk, t0};
    const int lo = t0 - 511;
    attn_init(st);
    attn_sweep_pf2(st, qf, kb, vb, ZW, (lo > 0 ? lo : 0) >> 6, qblk, 0xffffffffu, sc, mf, lds, tid);
    const float f = g2 * (st.l > 0.f ? 1.0f / st.l : 0.f);
#pragma unroll
    for (int e = 0; e < 2; ++e)
#pragma unroll
      for (int i = 0; i < 8; ++i) ypk[e][i] = pk2(bflo(ypk[e][i]) + f * st.o[e][2 * i], bfhi(ypk[e][i]) + f * st.o[e][2 * i + 1]);
  }
  u16* yc = (u16*)p.out + tok * 2048 + head * 64;
#pragma unroll
  for (int e = 0; e < 2; ++e)
#pragma unroll
    for (int a4 = 0; a4 < 4; ++a4) {
      uint2 u; u.x = ypk[e][2 * a4]; u.y = ypk[e][2 * a4 + 1];
      *(uint2*)(yc + 32 * e + 8 * a4 + 4 * h) = u;
    }
}

DI void mem_item(const Params& p, int b, int mh, int qtile, char* lds, int tid) {
  const int lane = tid & 63, w = tid >> 6, r = lane & 31, h = lane >> 5;
  const long tok = (long)b * 2048 + qtile * 128 + 32 * w + r;
  bf16x8 qf[8];
  {
    const u16* qp = p.z + tok * ZW + 4608 + mh * 128 + 8 * h;
#pragma unroll
    for (int ks = 0; ks < 8; ++ks) qf[ks] = *(const bf16x8*)(qp + 16 * ks);
  }
  const u16* kb = p.kvm + (long)b * 256 * 1024 + mh * 128;
  const u16* vb = kb + 512;
  const float sc = 0.08838834764831845f * 1.4426950408889634f;
  u16* yc = (u16*)p.out + tok * 2048 + 1536 + mh * 128;
  {
    AttnState<4> st;
    attn_init(st);
    attn_sweep<128, false, 4, 0>(st, qf, kb, vb, 1024, 0, 3, 0xffffffffu, sc, [](int) { return true; }, lds, tid, nullptr, 0.f);
    const float il = st.l > 0.f ? 1.0f / st.l : 0.f;
#pragma unroll
    for (int e = 0; e < 4; ++e)
#pragma unroll
      for (int a4 = 0; a4 < 4; ++a4) {
        uint2 u; u.x = pk2(st.o[e][4 * a4] * il, st.o[e][4 * a4 + 1] * il); u.y = pk2(st.o[e][4 * a4 + 2] * il, st.o[e][4 * a4 + 3] * il);
        *(uint2*)(yc + 32 * e + 8 * a4 + 4 * h) = u;
      }
  }
}

DI void conv_silu_4tok(const u16* zcol, const u16* hcol, bool first, const float* cw, const float* cb, float scale, char* dst, int tk0, int dc) {
  u32x4 raw[7];
#pragma unroll
  for (int i = 0; i < 7; ++i) {
    const bool inchunk = (tk0 - 3 + i) >= 0;
    const u16* ptr = inchunk ? (zcol + (long)(i - 3) * ZW) : (hcol + (i < 3 ? i : 0) * 1024);
    const u32x4 v = *(const u32x4*)ptr;
    raw[i] = (inchunk || !first) ? v : (u32x4){0u, 0u, 0u, 0u};
  }
  float wv[4][8], bv[8];
#pragma unroll
  for (int t = 0; t < 4; ++t) {
    float4 a = *(const float4*)(cw + t * 1024), b = *(const float4*)(cw + t * 1024 + 4);
    wv[t][0] = a.x; wv[t][1] = a.y; wv[t][2] = a.z; wv[t][3] = a.w; wv[t][4] = b.x; wv[t][5] = b.y; wv[t][6] = b.z; wv[t][7] = b.w;
  }
  { float4 a = *(const float4*)cb, b = *(const float4*)(cb + 4); bv[0] = a.x; bv[1] = a.y; bv[2] = a.z; bv[3] = a.w; bv[4] = b.x; bv[5] = b.y; bv[6] = b.z; bv[7] = b.w; }
#pragma unroll
  for (int o = 0; o < 4; ++o) {
    float acc[8];
#pragma unroll
    for (int e = 0; e < 8; ++e) acc[e] = bv[e];
#pragma unroll
    for (int t = 0; t < 4; ++t) {
      const u32x4 rr = raw[o + t];
      acc[0] += wv[t][0] * bflo(rr.x); acc[1] += wv[t][1] * bfhi(rr.x);
      acc[2] += wv[t][2] * bflo(rr.y); acc[3] += wv[t][3] * bfhi(rr.y);
      acc[4] += wv[t][4] * bflo(rr.z); acc[5] += wv[t][5] * bfhi(rr.z);
      acc[6] += wv[t][6] * bflo(rr.w); acc[7] += wv[t][7] * bfhi(rr.w);
    }
    uint4 u;
    u.x = pk2(siluf_(acc[0]) * scale, siluf_(acc[1]) * scale); u.y = pk2(siluf_(acc[2]) * scale, siluf_(acc[3]) * scale);
    u.z = pk2(siluf_(acc[4]) * scale, siluf_(acc[5]) * scale); u.w = pk2(siluf_(acc[6]) * scale, siluf_(acc[7]) * scale);
    *(uint4*)(dst + (tk0 + o) * 272 + dc * 2) = u;
  }
}

DI void phase_ml_summaries(const Params& p, int tid) {
  const int lane = tid & 63, w = tid >> 6;
  for (int task = blockIdx.x * 4 + w; task < 1024; task += gridDim.x * 4) {
    const int bh = task >> 5, c = task & 31, b = bh >> 2, hh = bh & 3;
    const float* zfp = p.zf + ((long)b * 2048 + c * 64 + lane) * 64;
    const float ig = zfp[48 + hh] + p.gate_b[hh], fg = zfp[52 + hh] + p.gate_b[4 + hh];
    const float lf = fminf(fg, 0.f) - log1pf(__expf(-fabsf(fg)));
    float bs = lf;
#pragma unroll
    for (int o = 1; o < 64; o <<= 1) { const float t = __shfl_up(bs, o); if (lane >= o) bs += t; }
    float cm = ig - bs;
#pragma unroll
    for (int o = 1; o < 64; o <<= 1) { const float t = __shfl_up(cm, o); if (lane >= o) cm = fmaxf(cm, t); }
    if (lane == 63) { p.mlba[task * 2] = bs; p.mlba[task * 2 + 1] = cm; }
  }
}

DI void mlpre_item(const Params& p, int b, int hh, int j, char* lds, int tid) {
  const int lane = tid & 63, w = tid >> 6, r = lane & 31, h = lane >> 5;
  const int i16 = lane & 15, tq = i16 >> 2, tp = i16 & 3, blk = (lane >> 4) & 1;
  constexpr int STR = 272;
  char* Ql = lds; char* Kl = lds + 17408; char* Vl = lds + 34816; char* SQ = lds + 52224;
  float* fa = (float*)(lds + 61440);
  float* fM = fa + 64; float* fb = fM + 64; float* denp = fb + 64;   float* misc = denp + 128;
  const int tc0 = j * 64;
  const long tokb = (long)b * 2048 + tc0;
  float* sc = p.mlsc + (long)((b * 4 + hh) * 32 + j) * 320;
  if (w == 0) {
    const float* ba = p.mlba + (long)((b * 4 + hh) * 32) * 2;
    const float2 mine = (lane < j) ? *(const float2*)(ba + 2 * lane) : make_float2(0.f, 0.f);
    float m_prev = 0.f;
    for (int c = 0; c < j; ++c) {
      const float Bc = __shfl(mine.x, c), Ac = __shfl(mine.y, c);
      m_prev = Bc + fmaxf(m_prev, Ac);
    }
    const float* zfp = p.zf + (tokb + lane) * 64;
    const float ig = zfp[48 + hh] + p.gate_b[hh], fg = zfp[52 + hh] + p.gate_b[4 + hh];
    const float lf = fminf(fg, 0.f) - log1pf(__expf(-fabsf(fg)));
    float bs = lf;
#pragma unroll
    for (int o = 1; o < 64; o <<= 1) { const float t = __shfl_up(bs, o); if (lane >= o) bs += t; }
    const float a = ig - bs;
    float cm = a;
#pragma unroll
    for (int o = 1; o < 64; o <<= 1) { const float t = __shfl_up(cm, o); if (lane >= o) cm = fmaxf(cm, t); }
    const float M = fmaxf(m_prev, cm);
    fa[lane] = a; fM[lane] = M; fb[lane] = bs;
    const float M63 = __shfl(M, 63);
    sc[lane] = __expf(m_prev - M);
    sc[64 + lane] = __expf(-(bs + M));
    sc[192 + lane] = __expf(a - M63);
    if (lane == 0) { sc[256] = __expf(m_prev - M63); misc[0] = M63; }
  }
  {
    const int dc = (tid & 15) * 8, tk0 = (tid >> 4) * 4;
    const u16* zq = p.z + (tokb + tk0) * ZW + 2560 + hh * 128 + dc;
    const u16* hq = p.halo + ((long)(b * 32 + (j > 0 ? j - 1 : 0)) * 3) * 1024 + hh * 128 + dc;
    conv_silu_4tok(zq, hq, j == 0, p.conv_w + hh * 128 + dc, p.conv_b + hh * 128 + dc, 1.0f, Ql, tk0, dc);
    asm volatile("" ::: "memory");
    conv_silu_4tok(zq + 512, hq + 512, j == 0, p.conv_w + 512 + hh * 128 + dc, p.conv_b + 512 + hh * 128 + dc, 0.08838834764831845f, Kl, tk0, dc);
#pragma unroll
    for (int o = 0; o < 4; ++o) *(u32x4*)(Vl + (tk0 + o) * STR + dc * 2) = *(const u32x4*)(zq + 1024 + (long)o * ZW);
  }
  __syncthreads();
  if (w < 3) {
    const int st_ = (w == 2) ? 1 : 0, tt = (w >= 1) ? 1 : 0;
    f32x16 acc = zero16();
#pragma unroll
    for (int ks = 0; ks < 8; ++ks) {
      bf16x8 a = *(const bf16x8*)(Kl + (32 * st_ + r) * STR + (16 * ks + 8 * h) * 2);
      bf16x8 bq = *(const bf16x8*)(Ql + (32 * tt + r) * STR + (16 * ks + 8 * h) * 2);
      acc = MFMA(a, bq, acc);
    }
    const int tI = 32 * tt + r;
    const float Mt = fM[tI];
    float dsum = 0.f;
#pragma unroll
    for (int a4 = 0; a4 < 4; ++a4) {
      float v[4];
#pragma unroll
      for (int jj = 0; jj < 4; ++jj) {
        const int sI = 32 * st_ + 8 * a4 + 4 * h + jj;
        const float e = __expf(fa[sI] - Mt);
        v[jj] = (sI <= tI) ? acc[4 * a4 + jj] * e : 0.f;
        dsum += v[jj];
      }
      uint2 u; u.x = pk2(v[0], v[1]); u.y = pk2(v[2], v[3]);
      *(uint2*)(SQ + tI * 144 + (32 * st_ + 8 * a4 + 4 * h) * 2) = u;
    }
    dsum += __shfl_xor(dsum, 32);
    if (h == 0) denp[w * 32 + r] = dsum;
  } else {
    const int row = lane >> 1, hf = lane & 1;
    *(u32x4*)(SQ + row * 144 + 64 + hf * 32) = (u32x4){0u, 0u, 0u, 0u};
    *(u32x4*)(SQ + row * 144 + 64 + hf * 32 + 16) = (u32x4){0u, 0u, 0u, 0u};
  }
  __syncthreads();
  {
    bf16x8 vf[4];
#pragma unroll
    for (int kk = 0; kk < 4; ++kk) vf[kk] = tr_pair(Vl + (16 * kk + 8 * h + tq) * STR + (32 * w + 16 * blk + 4 * tp) * 2, 4 * STR);
#pragma unroll
    for (int tt = 0; tt < 2; ++tt) {
      f32x16 num = zero16();
#pragma unroll
      for (int kk = 0; kk < 2 + 2 * tt; ++kk) {
        bf16x8 bq = *(const bf16x8*)(SQ + (32 * tt + r) * 144 + (16 * kk + 8 * h) * 2);
        num = MFMA(vf[kk], bq, num);
      }
      u16* yo = (u16*)p.out + (tokb + 32 * tt + r) * 2048 + 1024 + hh * 128 + 32 * w + 4 * h;
#pragma unroll
      for (int a4 = 0; a4 < 4; ++a4) {
        uint2 u; u.x = pk2(num[4 * a4], num[4 * a4 + 1]); u.y = pk2(num[4 * a4 + 2], num[4 * a4 + 3]);
        *(uint2*)(yo + 8 * a4) = u;
      }
    }
    if (tid < 64) sc[128 + tid] = (tid < 32) ? denp[tid] : (denp[32 + (tid - 32)] + denp[64 + (tid - 32)]);
    {
      const int dcg = (tid & 15) * 8, tkg = (tid >> 4) * 4;
      const float4 g0 = *(const float4*)(p.head_g + hh * 128 + dcg), g1 = *(const float4*)(p.head_g + hh * 128 + dcg + 4);
#pragma unroll
      for (int o = 0; o < 4; ++o) {
        u16* op = p.z + (tokb + tkg + o) * ZW + 4096 + hh * 128 + dcg;
        const u32x4 ov = *(const u32x4*)op;
        u32x4 gv;
        gv.x = pk2(sigmoidf_(bflo(ov.x)) * g0.x, sigmoidf_(bfhi(ov.x)) * g0.y); gv.y = pk2(sigmoidf_(bflo(ov.y)) * g0.z, sigmoidf_(bfhi(ov.y)) * g0.w);
        gv.z = pk2(sigmoidf_(bflo(ov.z)) * g1.x, sigmoidf_(bfhi(ov.z)) * g1.y); gv.w = pk2(sigmoidf_(bflo(ov.w)) * g1.z, sigmoidf_(bfhi(ov.w)) * g1.w);
        *(u32x4*)op = gv;
      }
    }
    const int dc = (tid & 15) * 8, tk0 = (tid >> 4) * 4;
    u16* zq = p.z + (tokb + tk0) * ZW + 2560 + hh * 128 + dc;
#pragma unroll
    for (int o = 0; o < 4; ++o) {
      *(u32x4*)(zq + (long)o * ZW) = *(const u32x4*)(Ql + (tk0 + o) * STR + dc * 2);
      *(u32x4*)(zq + 512 + (long)o * ZW) = *(const u32x4*)(Kl + (tk0 + o) * STR + dc * 2);
    }
  }
  __syncthreads();
}

DI void mlchain_item(const Params& p, int b, int hh, char* lds, int tid) {
  const int lane = tid & 63, w = tid >> 6, r = lane & 31, h = lane >> 5;
  const int i16 = lane & 15, tq = i16 >> 2, tp = i16 & 3, blk = (lane >> 4) & 1;
  constexpr int STR = 272;
  char* Ql = lds; char* Kl = lds + 17408; char* Vl = lds + 34816;
  float* scl = (float*)(lds + 52224);
  float* ssq = scl + 320;
  float* nvec = ssq + 256;
  float* nqv = nvec + 256;
  float* npart = nqv + 64;
  f32x16 CT[4];
#pragma unroll
  for (int d = 0; d < 4; ++d) CT[d] = zero16();
  float nreg = 0.f;
  nvec[tid] = 0.f;
  if (tid < 64) nqv[tid] = 0.f;
  const int dc = (tid & 15) * 8, tk0 = (tid >> 4) * 4;
  const u16* zrow = p.z + ((long)b * 2048 + tk0) * ZW + 2560 + hh * 128 + dc;
  const float* scg = p.mlsc + (long)((b * 4 + hh) * 32) * 320;
  {
#pragma unroll
    for (int o = 0; o < 4; ++o) {
      const u32x4 vq = *(const u32x4*)(zrow + (long)o * ZW), vk = *(const u32x4*)(zrow + 512 + (long)o * ZW), vv = *(const u32x4*)(zrow + 1024 + (long)o * ZW);
      *(u32x4*)(Ql + (tk0 + o) * STR + dc * 2) = vq;
      *(u32x4*)(Kl + (tk0 + o) * STR + dc * 2) = vk;
      *(u32x4*)(Vl + (tk0 + o) * STR + dc * 2) = vv;
    }
    scl[tid] = scg[tid];
    if (tid < 64) scl[256 + tid] = scg[256 + tid];
  }
  __syncthreads();
  for (int c_ = 0; c_ < 32; ++c_) {
    int c = c_;
    asm volatile("" : "+s"(c));
    const long tokb = (long)b * 2048 + c * 64;
    const int cn = (c < 31) ? c + 1 : 31;
    const u16* zrn = zrow + (long)cn * 64 * ZW;
    u32x4 pq[4];
#pragma unroll
    for (int o = 0; o < 4; ++o) pq[o] = *(const u32x4*)(zrn + (long)o * ZW);
    const float psc0 = scg[cn * 320 + tid];
    const float psc1 = scg[cn * 320 + 256 + (tid & 63)];
    const float* nv = nvec + (c & 1) * 128;
    const float decay = scl[256];
    unsigned hvp[2][8];
    uint2 nia[2][4];
#pragma unroll
    for (int tt = 0; tt < 2; ++tt) {
      const u16* yi = (const u16*)p.out + (tokb + 32 * tt + r) * 2048 + 1024 + hh * 128 + 32 * w + 4 * h;
#pragma unroll
      for (int a4 = 0; a4 < 4; ++a4) nia[tt][a4] = *(const uint2*)(yi + 8 * a4);
    }
    f32x16 numv[2];
    numv[0] = zero16(); numv[1] = zero16();
#pragma unroll
    for (int dt = 0; dt < 4; ++dt) {
      bf16x8 bqv[2][2];
#pragma unroll
      for (int s2 = 0; s2 < 2; ++s2)
#pragma unroll
        for (int tt = 0; tt < 2; ++tt) {
          const char* qrow = Ql + (32 * tt + r) * STR + (32 * dt + 16 * s2 + 4 * h) * 2;
          bqv[s2][tt] = cat8(*(const s16x4*)qrow, *(const s16x4*)(qrow + 16));
        }
#pragma unroll
      for (int s2 = 0; s2 < 2; ++s2) {
        const bf16x8 a = pack8(CT[dt], s2);
        numv[0] = MFMA(a, bqv[s2][0], numv[0]);
        numv[1] = MFMA(a, bqv[s2][1], numv[1]);
      }
    }
#pragma unroll
    for (int tt = 0; tt < 2; ++tt) {
      const int tI = 32 * tt + r;
      const uint2 (&ni)[4] = nia[tt];
      const f32x16& num = numv[tt];
      const float an = nqv[tI];
      const float iw = scl[tI];
      const float den = scl[128 + tI] + iw * an;
      const float dn = fmaxf(fabsf(den), scl[64 + tI]);
      const float inv = 1.0f / dn;
      float ss = 0.f;
#pragma unroll
      for (int a4 = 0; a4 < 4; ++a4) {
        const float v0 = (bflo(ni[a4].x) + iw * num[4 * a4]) * inv, v1 = (bfhi(ni[a4].x) + iw * num[4 * a4 + 1]) * inv;
        const float v2 = (bflo(ni[a4].y) + iw * num[4 * a4 + 2]) * inv, v3 = (bfhi(ni[a4].y) + iw * num[4 * a4 + 3]) * inv;
        hvp[tt][2 * a4] = pk2(v0, v1); hvp[tt][2 * a4 + 1] = pk2(v2, v3);
        ss += v0 * v0 + v1 * v1 + v2 * v2 + v3 * v3;
      }
      ss += __shfl_xor(ss, 32);
      if (h == 0) ssq[w * 64 + tI] = ss;
    }
    {
      float p0 = 0.f, p1 = 0.f;
#pragma unroll
      for (int s4 = 0; s4 < 4; ++s4) {
        const float4 ws4 = *(const float4*)(scl + 192 + 16 * w + 4 * s4);
        const unsigned ka = *(const unsigned*)(Kl + (16 * w + 4 * s4) * STR + lane * 4), kb2 = *(const unsigned*)(Kl + (16 * w + 4 * s4 + 1) * STR + lane * 4);
        const unsigned kc2 = *(const unsigned*)(Kl + (16 * w + 4 * s4 + 2) * STR + lane * 4), kd = *(const unsigned*)(Kl + (16 * w + 4 * s4 + 3) * STR + lane * 4);
        p0 += ws4.x * bflo(ka) + ws4.y * bflo(kb2) + ws4.z * bflo(kc2) + ws4.w * bflo(kd);
        p1 += ws4.x * bfhi(ka) + ws4.y * bfhi(kb2) + ws4.z * bfhi(kc2) + ws4.w * bfhi(kd);
      }
      *(float2*)(npart + w * 128 + 2 * lane) = make_float2(p0, p1);
    }
    __syncthreads();
#pragma unroll
    for (int o = 0; o < 4; ++o) *(u32x4*)(Ql + (tk0 + o) * STR + dc * 2) = pq[o];
    u32x4 pk[4], pv[4];
#pragma unroll
    for (int o = 0; o < 4; ++o) { pk[o] = *(const u32x4*)(zrn + 512 + (long)o * ZW); pv[o] = *(const u32x4*)(zrn + 1024 + (long)o * ZW); }
    uint2 ogv[2][4];
#pragma unroll
    for (int tt = 0; tt < 2; ++tt)
#pragma unroll
      for (int a4 = 0; a4 < 4; ++a4) ogv[tt][a4] = *(const uint2*)(p.z + (tokb + 32 * tt + r) * ZW + 4096 + hh * 128 + 32 * w + 8 * a4 + 4 * h);
    {
#pragma unroll
      for (int dt = 0; dt < 4; ++dt)
#pragma unroll
        for (int i = 0; i < 16; ++i) CT[dt][i] *= decay;
#pragma unroll
      for (int kk = 0; kk < 4; ++kk) {
        const bf16x8 vfr = tr_pair(Vl + (16 * kk + 8 * h + tq) * STR + (32 * w + 16 * blk + 4 * tp) * 2, 4 * STR);
        const float4 w0 = *(const float4*)(scl + 192 + 16 * kk + 8 * h), w1 = *(const float4*)(scl + 192 + 16 * kk + 8 * h + 4);
        const u32x4 u = __builtin_bit_cast(u32x4, vfr);
        u32x4 o;
        o.x = pk2(bflo(u.x) * w0.x, bfhi(u.x) * w0.y); o.y = pk2(bflo(u.y) * w0.z, bfhi(u.y) * w0.w);
        o.z = pk2(bflo(u.z) * w1.x, bfhi(u.z) * w1.y); o.w = pk2(bflo(u.w) * w1.z, bfhi(u.w) * w1.w);
        const bf16x8 bw = __builtin_bit_cast(bf16x8, o);
        bf16x8 kf[4];
#pragma unroll
        for (int dt = 0; dt < 4; ++dt) kf[dt] = tr_pair(Kl + (16 * kk + 8 * h + tq) * STR + (32 * dt + 16 * blk + 4 * tp) * 2, 4 * STR);
#pragma unroll
        for (int dt = 0; dt < 4; ++dt) CT[dt] = MFMA(kf[dt], bw, CT[dt]);
      }
    }
    if (tid < 128) {
      const float nn = decay * nreg + ((npart[tid] + npart[128 + tid]) + (npart[256 + tid] + npart[384 + tid]));
      nreg = nn; nvec[((c + 1) & 1) * 128 + tid] = nn;
    }
    __syncthreads();
#pragma unroll
    for (int o = 0; o < 4; ++o) {
      *(u32x4*)(Kl + (tk0 + o) * STR + dc * 2) = pk[o];
      *(u32x4*)(Vl + (tk0 + o) * STR + dc * 2) = pv[o];
    }
    scl[tid] = psc0;
    if (tid < 64) scl[256 + tid] = psc1;
    {
      const int tn = 16 * w + (lane & 15), dq = lane >> 4;
      const float* nvn = nvec + ((c + 1) & 1) * 128 + 32 * dq;
      float an = 0.f;
#pragma unroll
      for (int d8 = 0; d8 < 4; ++d8) {
        const u32x4 qv = *(const u32x4*)(Ql + tn * STR + (32 * dq + 8 * d8) * 2);
        const float4 n0 = *(const float4*)(nvn + 8 * d8), n1 = *(const float4*)(nvn + 8 * d8 + 4);
        an += n0.x * bflo(qv.x) + n0.y * bfhi(qv.x) + n0.z * bflo(qv.y) + n0.w * bfhi(qv.y) + n1.x * bflo(qv.z) + n1.y * bfhi(qv.z) + n1.z * bflo(qv.w) + n1.w * bfhi(qv.w);
      }
      an += __shfl_xor(an, 16);
      an += __shfl_xor(an, 32);
      if (lane < 16) nqv[tn] = an;
    }
#pragma unroll
    for (int tt = 0; tt < 2; ++tt) {
      const int tI = 32 * tt + r;
      const float ss = ssq[tI] + ssq[64 + tI] + ssq[128 + tI] + ssq[192 + tI];
      const float rn = rsqrtf(ss * (1.0f / 128.0f) + 1e-6f);
      const long tokg = tokb + tI;
#pragma unroll
      for (int a4 = 0; a4 < 4; ++a4) {
        const int e0 = 32 * w + 8 * a4 + 4 * h;
        const uint2 og = ogv[tt][a4];
        uint2 u;
        u.x = pk2(bflo(hvp[tt][2 * a4]) * rn * bflo(og.x), bfhi(hvp[tt][2 * a4]) * rn * bfhi(og.x));
        u.y = pk2(bflo(hvp[tt][2 * a4 + 1]) * rn * bflo(og.y), bfhi(hvp[tt][2 * a4 + 1]) * rn * bfhi(og.y));
        *(uint2*)((u16*)p.out + tokg * 2048 + 1024 + hh * 128 + e0) = u;
      }
    }
    __syncthreads();
  }
  __syncthreads();
}

DI void phase_two(const Params& p, char* lds, int tid) {
  if (blockIdx.x == 0 && tid == 0) { int* c_ = p.ctr; asm volatile("" : "+s"(c_)); __hip_atomic_store(c_ + 1, 0, __ATOMIC_RELAXED, __HIP_MEMORY_SCOPE_AGENT); }
  int* sh_item = (int*)(lds + LDS_BYTES + 32);
  while (true) {
    if (tid == 0) *sh_item = atomicAdd(p.ctr, 1);
    __syncthreads();
    const int it = *sh_item;
    __syncthreads();
    if (it >= 128 + 1024) break;
    int tid2 = tid;
    asm volatile("" : "+v"(tid2));
    if (it < 128) compress_item(p, it, lds, tid2);
    else { const int q = it - 128; mlpre_item(p, (q & 31) >> 2, q & 3, q >> 5, lds, tid2); }
    __syncthreads();
  }
}

DI void phase_mixers(const Params& p, char* lds, int tid, int it_base, int it_end, bool do_chain) {
  if (blockIdx.x == 0 && tid == 0) { int* c_ = p.ctr; asm volatile("" : "+s"(c_)); __hip_atomic_store(c_ + 0, 0, __ATOMIC_RELAXED, __HIP_MEMORY_SCOPE_AGENT); }
  int* sh_item = (int*)(lds + LDS_BYTES + 32);
  const int half = gridDim.x >> 1;
  if (do_chain && blockIdx.x < 32) {
    int tid2 = tid;
    asm volatile("" : "+v"(tid2));
    if (ITEM_MASK & 1) mlchain_item(p, blockIdx.x >> 2, blockIdx.x & 3, lds, tid2);
    __syncthreads();
    if (tid == 0) __hip_atomic_store(p.ctr + 32 + blockIdx.x, 1, __ATOMIC_RELAXED, __HIP_MEMORY_SCOPE_AGENT);
  } else if (do_chain && half >= 32 && (int)blockIdx.x >= half && (int)blockIdx.x < half + 32) {
    if (tid == 0) {
      unsigned spins = 0;
      while (__hip_atomic_load(p.ctr + 32 + (blockIdx.x - half), __ATOMIC_RELAXED, __HIP_MEMORY_SCOPE_AGENT) == 0 && ++spins < (1u << 22)) __builtin_amdgcn_s_sleep(32);
    }
    __syncthreads();
  }
  while (true) {
    if (tid == 0) *sh_item = atomicAdd(p.ctr + 1, 1) + it_base;
    __syncthreads();
    const int it = *sh_item;
    __syncthreads();
    if (it >= it_end) break;
    int tid2 = tid;
    asm volatile("" : "+v"(tid2));
    if (it < 2048) { const int j = it; if (ITEM_MASK & 2) nsa_item(p, (j & 31) >> 2, j & 3, 63 - (j >> 5), lds, tid2); }
    else { const int j = it - 2048; if (ITEM_MASK & 4) mem_item(p, j >> 6, (j >> 4) & 3, j & 15, lds, tid2); }
    __syncthreads();
  }
}

DI void phase_merge(const Params& p, char* lds, int tid) {
  const int lane = tid & 63, w = tid >> 6, wm = w >> 1, wn = w & 1, r = lane & 31, h = lane >> 5;
  const u16* ycat = (const u16*)p.out;
  for (int it = 0;; ++it) {
    int mt, nt;
    if (!tile_xcd(it, 128, 8, mt, nt)) break;
    const long m0 = (long)mt * 128; const int n0 = nt * 128;
    unsigned ypk[2][2][8];
#pragma unroll
    for (int a = 0; a < 2; ++a)
#pragma unroll
      for (int c = 0; c < 2; ++c)
#pragma unroll
        for (int i = 0; i < 8; ++i) ypk[a][c][i] = 0u;
#pragma unroll 1
    for (int br = 0; br < 3; ++br) {
      f32x16 acc[2][2];
      for (int a = 0; a < 2; ++a) for (int c = 0; c < 2; ++c) acc[a][c] = zero16();
      gemm_kloop<false>(acc, APlain{p.hbuf + m0 * 1024, 1024}, p.WinT + (long)(5248 + br * 1024 + n0) * 1024, 1024, 1024, lds, tid);
      unsigned gpk[2][2][8];
#pragma unroll
      for (int a = 0; a < 2; ++a)
#pragma unroll
        for (int c = 0; c < 2; ++c)
#pragma unroll
          for (int i = 0; i < 8; ++i) gpk[a][c][i] = pk2(sigmoidf_(acc[a][c][2 * i]), sigmoidf_(acc[a][c][2 * i + 1]));
      for (int a = 0; a < 2; ++a) for (int c = 0; c < 2; ++c) acc[a][c] = zero16();
      const int Kb = (br == 0) ? 1024 : 512;
      const int off = (br == 0) ? 0 : (br == 1 ? 1024 : 1536);
      const u16* WT = (br == 0) ? p.WpnT : (br == 1 ? p.WpmlT : p.WpmemT);
      gemm_kloop<true>(acc, APlain{ycat + m0 * 2048 + off, 2048}, WT + (long)n0 * Kb, Kb, Kb, lds, tid);
#pragma unroll
      for (int a = 0; a < 2; ++a)
#pragma unroll
        for (int c = 0; c < 2; ++c)
#pragma unroll
          for (int i = 0; i < 8; ++i)
            ypk[a][c][i] = pk2(bflo(ypk[a][c][i]) + bflo(gpk[a][c][i]) * acc[a][c][2 * i], bfhi(ypk[a][c][i]) + bfhi(gpk[a][c][i]) * acc[a][c][2 * i + 1]);
    }
    {
      f32x16 yv[2][2];
#pragma unroll
      for (int a = 0; a < 2; ++a)
#pragma unroll
        for (int c = 0; c < 2; ++c)
#pragma unroll
          for (int i = 0; i < 8; ++i) { yv[a][c][2 * i] = bflo(ypk[a][c][i]); yv[a][c][2 * i + 1] = bfhi(ypk[a][c][i]); }
      store_tile_bf16(yv, p.ybuf + m0 * 1024 + n0, 1024, lds, tid);
    }
  }
}

DI void phase_gemm_ss(const u16* A, int lda, const u16* Bt, int K, u16* tout, float* ssp, char* lds, int tid) {
  for (int it = 0;; ++it) {
    int mt, nt;
    if (!tile_xcd(it, 64, 8, mt, nt)) break;
    const long m0 = (long)mt * 256; const int n0 = nt * 128;
    f32x16 acc[4][2];
    for (int a = 0; a < 4; ++a) for (int c = 0; c < 2; ++c) acc[a][c] = zero16();
    gemm_kloop256(acc, APlain{A + m0 * lda, lda}, Bt + (long)n0 * K, K, K, lds, tid);
    {
      int t3 = tid;
      asm volatile("" : "+v"(t3));
      const int wm = (t3 >> 7) & 1, wn = (t3 >> 6) & 1, r = t3 & 31, h = (t3 >> 5) & 1;
#pragma unroll
      for (int mi = 0; mi < 4; ++mi) {
        float ss = 0.f;
#pragma unroll
        for (int ni = 0; ni < 2; ++ni)
#pragma unroll
          for (int i = 0; i < 16; ++i) ss += acc[mi][ni][i] * acc[mi][ni][i];
        ss += __shfl_xor(ss, 32);
        if (h == 0) ssp[(m0 + EPI_M4(mi)) * 16 + nt * 2 + wn] = ss;
      }
    }
    store_tile256_bf16(acc, tout + m0 * 1024 + n0, 1024, lds, tid);
  }
}

DI void phase_rows1(const Params& p, int tid) {
  const int lane = tid & 63, w = tid >> 6;
  const int stride = gridDim.x * 4;
  for (int row0 = blockIdx.x * 4 + w; row0 < T_TOK; row0 += 4 * stride) {
    float ssv[4]; float4 xv[4][4]; uint2 tb[4][4];
#pragma unroll
    for (int k = 0; k < 4; ++k) {
      const int row = (row0 + k * stride < T_TOK) ? row0 + k * stride : row0;
      ssv[k] = (lane < 16) ? p.ssp[(long)row * 16 + lane] : 0.f;
#pragma unroll
      for (int i = 0; i < 4; ++i) {
        xv[k][i] = ldnt4(p.x + (long)row * 1024 + 4 * (lane + 64 * i));
        tb[k][i] = ldnt2u(p.t1 + (long)row * 1024 + 4 * (lane + 64 * i));
      }
    }
#pragma unroll
    for (int k = 0; k < 4; ++k) {
      const int row = row0 + k * stride;
      if (row < T_TOK) {
        const float rn = rsqrtf(wave_sum(ssv[k]) * (1.0f / 1024.0f) + 1e-6f);
        float4 v[4]; float s2 = 0.f;
#pragma unroll
        for (int i = 0; i < 4; ++i) {
          const float4 tv = make_float4(bflo(tb[k][i].x), bfhi(tb[k][i].x), bflo(tb[k][i].y), bfhi(tb[k][i].y));
          const float4 gg = ((const float4*)p.g_post_mix)[lane + 64 * i];
          v[i].x = xv[k][i].x + tv.x * rn * gg.x; v[i].y = xv[k][i].y + tv.y * rn * gg.y; v[i].z = xv[k][i].z + tv.z * rn * gg.z; v[i].w = xv[k][i].w + tv.w * rn * gg.w;
          s2 += v[i].x * v[i].x + v[i].y * v[i].y + v[i].z * v[i].z + v[i].w * v[i].w;
          ((float4*)(p.out + (long)row * 1024))[lane + 64 * i] = v[i];
        }
        const float rn2 = rsqrtf(wave_sum(s2) * (1.0f / 1024.0f) + 1e-6f);
#pragma unroll
        for (int i = 0; i < 4; ++i) {
          const float4 gg = ((const float4*)p.g_pre_ffn)[lane + 64 * i];
          uint2 o; o.x = pk2(v[i].x * rn2 * gg.x, v[i].y * rn2 * gg.y); o.y = pk2(v[i].z * rn2 * gg.z, v[i].w * rn2 * gg.w);
          ((uint2*)(p.hbuf + (long)row * 1024))[lane + 64 * i] = o;
        }
      }
    }
  }
}

DI void phase_ffn_in(const Params& p, char* lds, int tid) {
  for (int it = 0;; ++it) {
    int mt, nt;
    if (!tile_xcd(it, 64, 44, mt, nt)) break;
    const long m0 = (long)mt * 256;
    f32x16 acc[4][2];
    for (int a = 0; a < 4; ++a) for (int c = 0; c < 2; ++c) acc[a][c] = zero16();
    gemm_kloop256(acc, APlain{p.hbuf + m0 * 1024, 1024}, p.WffT + (long)nt * 128 * 1024, 1024, 1024, lds, tid);
    int t3 = tid;
    asm volatile("" : "+v"(t3));
    const int wm = (t3 >> 7) & 1, wn = (t3 >> 6) & 1, r = t3 & 31, h = (t3 >> 5) & 1;
#pragma unroll
    for (int mi = 0; mi < 4; ++mi)
#pragma unroll
      for (int a4 = 0; a4 < 4; ++a4) {
        uint2 u;
        u.x = pk2(siluf_(acc[mi][0][4 * a4]) * acc[mi][1][4 * a4], siluf_(acc[mi][0][4 * a4 + 1]) * acc[mi][1][4 * a4 + 1]);
        u.y = pk2(siluf_(acc[mi][0][4 * a4 + 2]) * acc[mi][1][4 * a4 + 2], siluf_(acc[mi][0][4 * a4 + 3]) * acc[mi][1][4 * a4 + 3]);
        *(uint2*)(lds + EPI_M4(mi) * 144 + (wn * 32 + 8 * a4 + 4 * h) * 2) = u;
      }
    __syncthreads();
#pragma unroll
    for (int i = 0; i < 8; ++i) {
      const int c = t3 + 256 * i, row = c >> 3, cc = c & 7;
      *(u32x4*)(p.act + (m0 + row) * 2816 + nt * 64 + cc * 8) = *(const u32x4*)(lds + row * 144 + cc * 16);
    }
    __syncthreads();
  }
}

DI void phase_rows2(const Params& p, int tid) {
  const int lane = tid & 63, w = tid >> 6;
  const int stride = gridDim.x * 4;
  for (int row0 = blockIdx.x * 4 + w; row0 < T_TOK; row0 += 4 * stride) {
    float ssv[4]; float4 xv[4][4]; uint2 tb[4][4];
#pragma unroll
    for (int k = 0; k < 4; ++k) {
      const int row = (row0 + k * stride < T_TOK) ? row0 + k * stride : row0;
      ssv[k] = (lane < 16) ? p.ssp[(long)row * 16 + lane] : 0.f;
#pragma unroll
      for (int i = 0; i < 4; ++i) {
        xv[k][i] = ldnt4(p.out + (long)row * 1024 + 4 * (lane + 64 * i));
        tb[k][i] = ldnt2u(p.t2 + (long)row * 1024 + 4 * (lane + 64 * i));
      }
    }
#pragma unroll
    for (int k = 0; k < 4; ++k) {
      const int row = row0 + k * stride;
      if (row < T_TOK) {
        const float rn = rsqrtf(wave_sum(ssv[k]) * (1.0f / 1024.0f) + 1e-6f);
#pragma unroll
        for (int i = 0; i < 4; ++i) {
          const float4 tv = make_float4(bflo(tb[k][i].x), bfhi(tb[k][i].x), bflo(tb[k][i].y), bfhi(tb[k][i].y));
          const float4 gg = ((const float4*)p.g_post_ffn)[lane + 64 * i];
          float4 o = xv[k][i];
          o.x += tv.x * rn * gg.x; o.y += tv.y * rn * gg.y; o.z += tv.z * rn * gg.z; o.w += tv.w * rn * gg.w;
          stnt4(p.out + (long)row * 1024 + 4 * (lane + 64 * i), o);
        }
      }
    }
  }
}

__global__ void __launch_bounds__(256, 2) hybrid_fwd(Params p, int ph_lo, int ph_hi, unsigned long long prog) {
  extern __shared__ __attribute__((aligned(16))) char lds[];
  const int wave_id = __builtin_amdgcn_readfirstlane((int)(threadIdx.x >> 6));
  if (threadIdx.x == 0) *(uint4*)(lds + LDS_BYTES) = make_uint4(0u, 0u, 0u, 0u);
  __syncthreads();
  XcdBarrier xb = xcd_barrier_post(p.bar, (volatile LAS unsigned*)(lds + LDS_BYTES));
  for (int pi = ph_lo; pi < ph_hi; ++pi) {
    const int ph = (int)((prog >> (4 * pi)) & 15ull);
    unsigned zero_ = 0u;
    asm volatile("" : "+s"(zero_));
    int tid = wave_id * 64 + (int)__builtin_amdgcn_mbcnt_hi(~0u, __builtin_amdgcn_mbcnt_lo(~0u, zero_));
    asm volatile("" : "+v"(tid));
    switch (ph) {
#define ON(n) (ONLY < 0 || ONLY == n)
      case 0: if (ON(0)) phase_prep(p, lds, tid); break;
      case 1: if (ON(1)) phase_gemm_in(p, lds, tid); break;
      case 14: phase_ml_summaries(p, tid); break;
      case 15: if (blockIdx.x == 0 && tid == 0) { int* c_ = p.ctr; asm volatile("" : "+s"(c_)); __hip_atomic_store(c_ + 0, 0, __ATOMIC_RELAXED, __HIP_MEMORY_SCOPE_AGENT); } break;
      case 2: if (ON(2)) phase_two(p, lds, tid); break;
      case 13: if (blockIdx.x == 0 && tid == 0) { int* c_ = p.ctr; asm volatile("" : "+s"(c_)); __hip_atomic_store(c_ + 1, 0, __ATOMIC_RELAXED, __HIP_MEMORY_SCOPE_AGENT); } break;
      case 3: case 10: case 11: case 12: if (ON(3)) phase_mixers(p, lds, tid, ph == 12 ? 2048 : 0, ph == 11 ? 2048 : 2560, ph == 3); break;
      case 4: if (ON(4)) phase_merge(p, lds, tid); break;
      case 5: if (ON(5)) phase_gemm_ss(p.ybuf, 1024, p.WoutT, 1024, p.t1, p.ssp, lds, tid); break;
      case 6: if (ON(6)) phase_rows1(p, tid); break;
      case 7: if (ON(7)) phase_ffn_in(p, lds, tid); break;
      case 8: if (ON(8)) phase_gemm_ss(p.act, 2816, p.WdnT, 2816, p.t2, p.ssp, lds, tid); break;
      default: if (ON(9)) phase_rows2(p, tid); break;
    }
    if (pi + 1 < ph_hi) {
      if (ph_hi > 1000) cg::this_grid().sync();
      xcd_barrier(xb, tid);
    }
  }
}

extern "C" void kernel_launch(void* const* d_in, const int* in_sizes, int n_in, void* d_out, int out_size, void* d_ws, size_t ws_size,
                              hipStream_t stream) {
  static int grid = 0;
  if (grid == 0) {
    int dev = 0, cus = 0, per_cu = 0;
    hipGetDevice(&dev);
    hipDeviceGetAttribute(&cus, hipDeviceAttributeMultiprocessorCount, dev);
    hipFuncSetAttribute((const void*)hybrid_fwd, hipFuncAttributeMaxDynamicSharedMemorySize, LDS_TOTAL);
    hipOccupancyMaxActiveBlocksPerMultiprocessor(&per_cu, (const void*)hybrid_fwd, 256, LDS_TOTAL);
    if (per_cu < 1) per_cu = 1;
    if (per_cu > 2) per_cu = 2;
    grid = cus * per_cu;
    grid -= grid % 8;
    if (grid < 8) grid = 8;
  }
  Params p{};
  const float** ins = (const float**)&p;
  for (int i = 0; i < 25; ++i) ins[i] = (const float*)d_in[i];
  p.out = (float*)d_out;
  char* ws = (char*)d_ws;
  size_t off = 0;
  auto take = [&](size_t bytes) { char* q = ws + off; off += (bytes + 255) & ~(size_t)255; return q; };
  char* zreg = take((size_t)T_TOK * ZW * 2);
  p.z = (u16*)zreg;
  p.ybuf = (u16*)zreg;
  p.t1 = (u16*)(zreg + ((size_t)32 << 20));
  p.act = (u16*)zreg;
  p.t2 = (u16*)(zreg + ((size_t)96 << 20));
  p.hbuf = (u16*)take((size_t)T_TOK * 1024 * 2);
  p.WinT = (u16*)take((size_t)8320 * 1024 * 2);
  p.WffT = (u16*)take((size_t)5632 * 1024 * 2);
  p.WdnT = (u16*)take((size_t)1024 * 2816 * 2);
  p.WmkvT = (u16*)take((size_t)1024 * 1024 * 2);
  p.WpnT = (u16*)take((size_t)1024 * 1024 * 2);
  p.WpmlT = (u16*)take((size_t)1024 * 512 * 2);
  p.WpmemT = (u16*)take((size_t)1024 * 512 * 2);
  p.WoutT = (u16*)take((size_t)1024 * 1024 * 2);
  p.W1kT = (u16*)take((size_t)128 * 2048 * 2);
  p.W1vT = (u16*)take((size_t)128 * 2048 * 2);
  p.memn = (u16*)take((size_t)2048 * 1024 * 2);
  p.kvm = (u16*)take((size_t)2048 * 1024 * 2);
  p.kc = (u16*)take((size_t)32 * 128 * 64 * 2);
  p.vc = (u16*)take((size_t)32 * 128 * 64 * 2);
  p.zf = (float*)take((size_t)T_TOK * 64 * 4);
  p.ssp = (float*)take((size_t)T_TOK * 16 * 4);
  p.cbias = (float*)take((256 + 32 * 128) * 4);
  p.ctr = (int*)take(256);
  p.mlsc = (float*)take((size_t)1024 * 320 * 4);
  p.mlba = (float*)take((size_t)1024 * 2 * 4);
  p.halo = (u16*)take((size_t)256 * 3 * 1024 * 2);
  p.bar = (unsigned*)take((size_t)XCD_BAR_WORDS * 4);
  if (off > ws_size) { fprintf(stderr, "kernel_launch: workspace too small (%zu needed, %zu given)\n", off, ws_size); return; }
  hipMemsetAsync(p.bar, 0, (size_t)XCD_BAR_WORDS * 4, stream);
#ifndef PROG
 #define PROG {0, 1, 2, 3, 4, 5, 6, 7, 8, 9}
#endif
  const int progl[] = PROG;
  unsigned long long prog = 0ull; int nprog = 0;
  for (int ph : progl) prog |= (unsigned long long)ph << (4 * nprog++);
#if COOP
  int lo = 0, hi = nprog;
  void* args[] = {&p, &lo, &hi, &prog};
  hipError_t e = hipLaunchCooperativeKernel((const void*)hybrid_fwd, dim3(grid), dim3(256), args, LDS_TOTAL, stream);
  if (e != hipSuccess) fprintf(stderr, "cooperative launch failed: %s (grid %d)\n", hipGetErrorString(e), grid);
#else
  for (int ph = 0; ph < nprog; ++ph) hipLaunchKernelGGL(hybrid_fwd, dim3(grid), dim3(256), LDS_TOTAL, stream, p, ph, ph + 1, prog);
#endif
}
```
